# Optimizing an MI355X kernel written in HIP

```python
import jax
import jax.numpy as jnp
from jax import lax
import numpy as np

D_MODEL = 1024
BATCH = 4
SEQ = 4096
DEPTH = 2
DEC_BATCH = 128
DEC_SEQ = 1
PAST_LEN = 2048
PAGE_SIZE = 128

D_MIX = D_MODEL
HEAD_DIM = 64
D_NSA = D_MIX // 2
N_HEADS = D_NSA // HEAD_DIM
N_KV = 2
GROUP = N_HEADS // N_KV
D_KV = 2 * N_KV * HEAD_DIM
CMP_BLOCK = 64
N_SELECT = 16
WINDOW = 512
Q_BLOCK = 64
D_POOL = D_MIX // 4
POOL_WINDOWS = (2, 4, 8, 16)
N_POOL_GROUPS = 4
POOL_GROUP_DIM = D_POOL // N_POOL_GROUPS
POOL_MAX = 16
D_GMLP = D_MIX - D_NSA - D_POOL
N_GMLP_GROUPS = 4
GMLP_GROUP_DIM = D_GMLP // N_GMLP_GROUPS
CHUNK = 128
D_IN = 2 * D_NSA + 3 * D_KV + 3 * N_HEADS + 2 * D_POOL + 3 * D_GMLP
EPS = 1e-6
NEG_INF = -1e30
SEL_FORCED = 1e4
SEL_INVALID = -1e4

kernel_name = 'hymba_nsa_pool_gmlp_step'


def rms_norm(x, g):
    xf = x.astype(jnp.float32)
    y = xf * lax.rsqrt(jnp.mean(xf * xf, axis=-1, keepdims=True) + EPS)
    return (y * g.astype(jnp.float32)).astype(x.dtype)


def masked_softmax(s, mask):
    s = jnp.where(mask, s, NEG_INF)
    p = jnp.exp(s - jnp.max(s, axis=-1, keepdims=True)) * mask
    return p / jnp.maximum(jnp.sum(p, axis=-1, keepdims=True), 1e-30)


def alibi_slopes():
    h = jnp.arange(1, N_HEADS + 1, dtype=jnp.float32)
    return jnp.exp2(-8.0 * h / N_HEADS).reshape(N_KV, GROUP)


def project(h, w):
    p = jnp.einsum('btd,de->bte', h, w)
    sizes = (D_NSA, D_KV, D_KV, D_KV, 3 * N_HEADS, D_NSA, D_POOL, D_POOL, D_GMLP, D_GMLP, D_GMLP)
    return jnp.split(p, np.cumsum(sizes)[:-1].tolist(), axis=-1)


def compress_blocks(kv, pe, w1, w2):
    b, L = kv.shape[0], kv.shape[1]
    n = L // CMP_BLOCK
    blocks = kv[:, :n * CMP_BLOCK].astype(jnp.float32).reshape(b, n, CMP_BLOCK, 2, N_KV, HEAD_DIM)
    blocks = blocks + jnp.swapaxes(pe, 0, 1)[None, None, :, :, None, :]
    hid = jax.nn.silu(jnp.einsum('bncrkd,rde->bncrke', blocks, w1))
    return jnp.einsum('bnrkd,rde->bnrke', jnp.mean(hid, axis=2), w2)


def nsa_attend(q, gates, kv_cmp, kv_sel, kv_win, q_pos0, win_pos0, pe, w1, w2):
    f32 = jnp.float32
    b, tq = q.shape[0], q.shape[1]
    L = kv_sel.shape[1]
    slopes = alibi_slopes()
    sl5 = slopes[None, None, :, :, None]
    qf = q.astype(f32).reshape(b, tq, N_KV, GROUP, HEAD_DIM) * (HEAD_DIM ** -0.5)
    t_pos = q_pos0 + jnp.arange(tq)
    kvc = compress_blocks(kv_cmp, pe.astype(f32), w1.astype(f32), w2.astype(f32))
    n_cmp = kvc.shape[1]
    dist_c = t_pos[:, None] - ((jnp.arange(n_cmp) + 1) * CMP_BLOCK - 1)[None, :]
    s_c = jnp.einsum('bqkgd,bnkd->bqkgn', qf, kvc[:, :, 0]) - sl5 * dist_c.astype(f32)[None, :, None, None, :]
    p_c = masked_softmax(s_c, (dist_c >= 0)[None, :, None, None, :])
    o_c = jnp.einsum('bqkgn,bnkd->bqkgd', p_c, kvc[:, :, 1])
    n_blk = -(-L // CMP_BLOCK)
    k_eff = min(N_SELECT, n_blk)
    imp = jnp.pad(jnp.sum(p_c, axis=3), ((0, 0), (0, 0), (0, 0), (0, n_blk - n_cmp)))
    blk = jnp.arange(n_blk)
    cur = t_pos // CMP_BLOCK
    forced = (blk[None, :] == cur[:, None]) | (blk[None, :] == 0)
    started = blk[None, :] <= cur[:, None]
    score = jnp.where(forced[None, :, None, :], SEL_FORCED,
                      jnp.where(started[None, :, None, :], imp, SEL_INVALID))
    top_val, top_idx = lax.top_k(score, k_eff)
    top_ok = top_val > SEL_INVALID * 0.5
    kb = jnp.pad(kv_sel.astype(f32), ((0, 0), (0, n_blk * CMP_BLOCK - L), (0, 0), (0, 0), (0, 0)))
    kb = kb.reshape(b, n_blk, CMP_BLOCK, 2, N_KV, HEAD_DIM).transpose(0, 4, 1, 2, 3, 5)
    kvw = jnp.pad(kv_win.astype(f32), ((0, 0), (WINDOW, 0), (0, 0), (0, 0), (0, 0)))
    qblk = Q_BLOCK if tq % Q_BLOCK == 0 else tq
    n_qb = tq // qblk

    def to_blocks(a):
        return a.reshape((b, n_qb, qblk) + a.shape[2:]).swapaxes(0, 1)

    def from_blocks(a):
        return a.swapaxes(0, 1).reshape((b, tq) + a.shape[3:])

    bi = jnp.arange(b)[:, None, None, None]
    ki = jnp.arange(N_KV)[None, None, :, None]
    w_off = jnp.arange(WINDOW + qblk)
    in_blk = jnp.arange(CMP_BLOCK)

    def sweep(args):
        qi, idx, ok, start = args
        tqb = q_pos0 + start + jnp.arange(qblk)
        g = kb[bi, ki, idx].reshape(b, qblk, N_KV, k_eff * CMP_BLOCK, 2, HEAD_DIM)
        s_pos = (idx[..., None] * CMP_BLOCK + in_blk).reshape(b, qblk, N_KV, k_eff * CMP_BLOCK)
        dist_s = tqb[None, :, None, None] - s_pos
        mask_s = (dist_s >= 0) & jnp.repeat(ok, CMP_BLOCK, axis=-1)
        s_s = jnp.einsum('bqkgd,bqksd->bqkgs', qi, g[..., 0, :]) - sl5 * dist_s.astype(f32)[:, :, :, None, :]
        o_s = jnp.einsum('bqkgs,bqksd->bqkgd', masked_softmax(s_s, mask_s[:, :, :, None, :]), g[..., 1, :])
        wk = lax.dynamic_slice_in_dim(kvw, q_pos0 + start - win_pos0, WINDOW + qblk, axis=1)
        w_pos = q_pos0 + start - WINDOW + w_off
        dist_w = tqb[:, None] - w_pos[None, :]
        mask_w = (dist_w >= 0) & (dist_w < WINDOW) & (w_pos >= win_pos0)[None, :]
        s_w = jnp.einsum('bqkgd,bskd->bqkgs', qi, wk[:, :, 0]) - sl5 * dist_w.astype(f32)[None, :, None, None, :]
        o_w = jnp.einsum('bqkgs,bskd->bqkgd', masked_softmax(s_w, mask_w[None, :, None, None, :]), wk[:, :, 1])
        return o_s, o_w

    o_s, o_w = lax.map(sweep, (to_blocks(qf), to_blocks(top_idx), to_blocks(top_ok), jnp.arange(n_qb) * qblk))
    o_s = from_blocks(o_s)
    o_w = from_blocks(o_w)
    gf = gates.astype(f32).reshape(b, tq, N_KV, GROUP, 3)
    o = gf[..., 0:1] * o_c + gf[..., 1:2] * o_s + gf[..., 2:3] * o_w
    return o.reshape(b, tq, D_NSA)


def pool_mix(xin, prev, pos0, w_pool, scale):
    b, t = xin.shape[0], xin.shape[1]
    xf = jnp.concatenate([prev, xin], axis=1).astype(jnp.float32)
    cs = jnp.cumsum(jnp.pad(xf, ((0, 0), (1, 0), (0, 0))), axis=1)
    hi = cs[:, POOL_MAX:]
    pos = pos0 + jnp.arange(t)
    pooled = []
    for gi, w in enumerate(POOL_WINDOWS):
        sl = slice(gi * POOL_GROUP_DIM, (gi + 1) * POOL_GROUP_DIM)
        lo = cs[:, POOL_MAX - w:POOL_MAX - w + t, sl]
        cnt = jnp.minimum(w, pos + 1).astype(jnp.float32)[None, :, None]
        pooled.append((hi[:, :, sl] - lo) / cnt)
    diff = (jnp.concatenate(pooled, axis=-1) - xf[:, POOL_MAX - 1:]).reshape(b, t, N_POOL_GROUPS, POOL_GROUP_DIM)
    y = jnp.einsum('btgc,gce->btge', diff, w_pool).reshape(b, t, D_POOL)
    return y * scale


def gmlp_mix(u, v, g_norm, ws, bs, rows):
    b, t = u.shape[0], u.shape[1]
    vg = v.astype(jnp.float32).reshape(b, t, N_GMLP_GROUPS, GMLP_GROUP_DIM)
    vn = vg * lax.rsqrt(jnp.mean(vg * vg, axis=-1, keepdims=True) + EPS) \
        * g_norm.astype(jnp.float32).reshape(N_GMLP_GROUPS, GMLP_GROUP_DIM)
    n = t // rows
    w = ws[:, :rows, :rows] * jnp.tril(jnp.ones((rows, rows), dtype=ws.dtype))
    s = jnp.einsum('gij,bnjgc->bnigc', w, vn.reshape(b, n, rows, N_GMLP_GROUPS, GMLP_GROUP_DIM))
    s = s + jnp.swapaxes(bs[:, :rows], 0, 1)[None, None, :, :, None]
    return u * s.reshape(b, t, D_GMLP), vn.reshape(b, t, D_GMLP).astype(v.dtype)


def merge_groups(x, ya, za, yb, zb, yc, zc, w_out, g_post):
    mix = jnp.concatenate([ya * jax.nn.silu(za), yb * jax.nn.silu(zb), yc * jax.nn.silu(zc)], axis=-1)
    out = jnp.einsum('bte,ed->btd', mix, w_out)
    return x + rms_norm(out, g_post).astype(x.dtype)


def setup_inputs(seed: int = 0) -> dict:
    key = jax.random.key(seed)
    k = jax.random.split(key, 20)
    f32 = jnp.float32
    n_pages = PAST_LEN // PAGE_SIZE
    n_used = DEC_BATCH * n_pages
    n_phys = n_used + max(1, n_used // 4)
    win_keep = min(WINDOW, PAST_LEN)

    def nrm(kk, shape, s=1.0):
        return s * jax.random.normal(kk, shape, f32)

    page_table = jax.random.permutation(k[0], n_phys)[:n_used].reshape(DEC_BATCH, n_pages).astype(jnp.int32)
    return {
        'x_prompt': nrm(k[1], (BATCH, SEQ, D_MODEL)),
        'x_sample': nrm(k[2], (DEC_BATCH, DEC_SEQ, D_MODEL)),
        'cache_kv_cmp': nrm(k[3], (DEPTH, n_phys, PAGE_SIZE, 2, N_KV, HEAD_DIM)),
        'cache_kv_sel': nrm(k[4], (DEPTH, n_phys, PAGE_SIZE, 2, N_KV, HEAD_DIM)),
        'cache_kv_win': nrm(k[5], (DEPTH, DEC_BATCH, win_keep, 2, N_KV, HEAD_DIM)),
        'state_pool': nrm(k[6], (DEPTH, DEC_BATCH, POOL_MAX - 1, D_POOL)),
        'page_table': page_table,
        'norm_pre': 1.0 + nrm(k[7], (DEPTH, D_MODEL), 0.02),
        'w_in': nrm(k[8], (DEPTH, D_MODEL, D_IN), D_MODEL ** -0.5),
        'cmp_pe': nrm(k[9], (DEPTH, 2, CMP_BLOCK, HEAD_DIM), 0.1),
        'cmp_w1': nrm(k[10], (DEPTH, 2, HEAD_DIM, HEAD_DIM), HEAD_DIM ** -0.5),
        'cmp_w2': nrm(k[11], (DEPTH, 2, HEAD_DIM, HEAD_DIM), HEAD_DIM ** -0.5),
        'pool_w': nrm(k[12], (DEPTH, N_POOL_GROUPS, POOL_GROUP_DIM, POOL_GROUP_DIM), POOL_GROUP_DIM ** -0.5),
        'pool_scale': 1.0 + nrm(k[13], (DEPTH, D_POOL), 0.02),
        'gmlp_norm': 1.0 + nrm(k[14], (DEPTH, D_GMLP), 0.02),
        'gmlp_ws': nrm(k[15], (DEPTH, N_GMLP_GROUPS, CHUNK, CHUNK), CHUNK ** -0.5),
        'gmlp_bs': 1.0 + nrm(k[16], (DEPTH, N_GMLP_GROUPS, CHUNK), 0.02),
        'w_out': nrm(k[17], (DEPTH, D_MIX, D_MODEL), D_MIX ** -0.5),
        'norm_post': 1.0 + nrm(k[18], (DEPTH, D_MODEL), 0.02),
    }


def reference(x_prompt, x_sample, cache_kv_cmp, cache_kv_sel, cache_kv_win, state_pool, page_table,
              norm_pre, w_in, cmp_pe, cmp_w1, cmp_w2, pool_w, pool_scale, gmlp_norm, gmlp_ws, gmlp_bs,
              w_out, norm_post):
    bp, tp = x_prompt.shape[0], x_prompt.shape[1]
    bs_, ts = x_sample.shape[0], x_sample.shape[1]
    past_len = page_table.shape[1] * PAGE_SIZE
    win_keep = cache_kv_win.shape[2]
    xp, xs = x_prompt, x_sample
    kvc_p, kvc_s, kvs_p, kvs_s, kvw_p, kvw_s, pool_p, pool_s, gv_p, gv_s = ([] for _ in range(10))
    for l in range(DEPTH):
        q, kc, ks, kw, gl, za, pin, zb, u, v, zc = project(rms_norm(xp, norm_pre[l]), w_in[l])
        kc, ks, kw = [a.reshape(bp, tp, 2, N_KV, HEAD_DIM) for a in (kc, ks, kw)]
        gates = jax.nn.sigmoid(gl.astype(jnp.float32)).reshape(bp, tp, N_HEADS, 3)
        ya = nsa_attend(q.reshape(bp, tp, N_HEADS, HEAD_DIM), gates, kc, ks, kw, 0, 0,
                        cmp_pe[l], cmp_w1[l], cmp_w2[l])
        yb = pool_mix(pin, jnp.zeros((bp, POOL_MAX - 1, D_POOL), pin.dtype), 0, pool_w[l], pool_scale[l])
        yc, vn = gmlp_mix(u, v, gmlp_norm[l], gmlp_ws[l], gmlp_bs[l], CHUNK)
        xp = merge_groups(xp, ya, za, yb, zb, yc, zc, w_out[l], norm_post[l])
        kvc_p.append(kc)
        kvs_p.append(ks)
        kvw_p.append(kw[:, tp - min(WINDOW, tp):])
        pool_p.append(pin[:, tp - (POOL_MAX - 1):])
        gv_p.append(vn[:, tp - CHUNK:])
        q, kc, ks, kw, gl, za, pin, zb, u, v, zc = project(rms_norm(xs, norm_pre[l]), w_in[l])
        kc, ks, kw = [a.reshape(bs_, ts, 2, N_KV, HEAD_DIM) for a in (kc, ks, kw)]
        gates = jax.nn.sigmoid(gl.astype(jnp.float32)).reshape(bs_, ts, N_HEADS, 3)
        kc_full = jnp.concatenate(
            [cache_kv_cmp[l][page_table].reshape(bs_, past_len, 2, N_KV, HEAD_DIM), kc], axis=1)
        ks_full = jnp.concatenate(
            [cache_kv_sel[l][page_table].reshape(bs_, past_len, 2, N_KV, HEAD_DIM), ks], axis=1)
        kw_full = jnp.concatenate([cache_kv_win[l], kw], axis=1)
        ya = nsa_attend(q.reshape(bs_, ts, N_HEADS, HEAD_DIM), gates, kc_full, ks_full, kw_full,
                        past_len, past_len - win_keep, cmp_pe[l], cmp_w1[l], cmp_w2[l])
        yb = pool_mix(pin, state_pool[l], past_len, pool_w[l], pool_scale[l])
        yc, vn = gmlp_mix(u, v, gmlp_norm[l], gmlp_ws[l], gmlp_bs[l], ts)
        xs = merge_groups(xs, ya, za, yb, zb, yc, zc, w_out[l], norm_post[l])
        kvc_s.append(kc)
        kvs_s.append(ks)
        kvw_s.append(kw_full[:, ts:])
        pool_s.append(jnp.concatenate([state_pool[l], pin], axis=1)[:, ts:])
        gv_s.append(vn)
    return (xp, xs,
            jnp.stack(kvc_p), jnp.stack(kvc_s),
            jnp.stack(kvs_p), jnp.stack(kvs_s),
            jnp.stack(kvw_p), jnp.stack(kvw_s),
            jnp.stack(pool_p), jnp.stack(pool_s),
            jnp.stack(gv_p), jnp.stack(gv_s))
```

```cpp
#include <hip/hip_runtime.h>
#include <cstdio>
#include <cstdint>
namespace pg8 {
#define PG8_LAS __attribute__((address_space(3)))
typedef unsigned short bf16_t;
typedef short bf16x8 __attribute__((ext_vector_type(8)));
typedef float f32x4 __attribute__((ext_vector_type(4)));
typedef unsigned u32x4 __attribute__((ext_vector_type(4)));
constexpr int BM = 256, BK = 64, HALF = 128, HTB = HALF * BK * 2  , STAGE_BYTES = 8 * HTB, NXCD = 8, WGM = 8;

__host__ __device__ __forceinline__ int lds_byte(int r, int c) { const int st = (r >> 4) * 2 + (c >> 5), rr = r & 15, cc = c & 31, ob = rr * 64 + cc * 2; return st * 1024 + (ob ^ (((ob >> 9) & 1) << 5)); }
__host__ __device__ __forceinline__ void stage_rc(int b, int& R, int& C) { const int st = b / 1024, sb = b % 1024, swz = sb ^ (((sb >> 9) & 1) << 5); R = (st >> 1) * 16 + swz / 64; C = (st & 1) * 32 + (swz % 64) / 2; }
__host__ __device__ __forceinline__ int perm32(int rho) { const int n = rho >> 4, i = rho & 15; return 8 * (i >> 2) + 4 * n + (i & 3); }

struct Unit { int pm, pn; };
struct Gemm { const bf16_t* A; const bf16_t* Bt; int M, N, K; };

struct StaticOrder {
    int nM, nN, nwg, G, c;
    __host__ __device__ void init(int M, int N, int G_, int c_) { nM = M / BM; nN = N / BM; nwg = nM * nN; G = G_; c = c_; }
    __host__ __device__ bool next(int i, Unit& u) const {
        const long L = (long)i * G + c; if (L >= nwg) return false;
        int wgid = (int)L; { const int q = nwg / NXCD, r = nwg % NXCD, xcd = wgid % NXCD, off = wgid / NXCD; wgid = (xcd < r ? xcd * (q + 1) : r * (q + 1) + (xcd - r) * q) + off; }
        const int nig = WGM * nN, gid = wgid / nig, fm = gid * WGM, gsz = (nM - fm) < WGM ? (nM - fm) : WGM;
        u.pm = fm + ((wgid % nig) % gsz); u.pn = (wgid % nig) / gsz; return true;
    }
    __device__ __forceinline__ void a_ready(const Unit&) const {}
    __device__ __forceinline__ void done(const Unit&) const {}
};
__device__ __forceinline__ unsigned cvt_pk_bf16(float lo, float hi) { unsigned r; asm volatile("v_cvt_pk_bf16_f32 %0, %1, %2" : "=v"(r) : "v"(lo), "v"(hi)); return r; }
typedef float f32x2 __attribute__((ext_vector_type(2)));
template <class Epi, class Sched, bool ALIGN_EPI = false, bool SP2 = false>
__device__ __forceinline__ void gemm_phase(PG8_LAS unsigned char* lds, const Gemm g, const Sched& S, const Epi& E, const int wave_id) {
    int lane_l = (int)__builtin_amdgcn_mbcnt_hi(~0u, __builtin_amdgcn_mbcnt_lo(~0u, 0u)); asm volatile("" : "+v"(lane_l));
    const int lane = lane_l, wid = wave_id, tid = wid * 64 + lane, wr = wid >> 2, wc = wid & 3, fr = lane & 15, fq = lane >> 4;
    const int K = g.K, nt = K / BK;
    unsigned voffA[2], voffB[2];
#pragma unroll
    for (int i = 0; i < 2; ++i) { int R, C; stage_rc(tid * 16 + i * 8192, R, C); const int Rb = Epi::PERM ? ((R & ~31) + perm32(R & 31)) : R;
        voffA[i] = (unsigned)(R * K + C) * 2u; voffB[i] = (unsigned)(Rb * K + C) * 2u; }
    const size_t kstep = (size_t)(BK * 2);
    const size_t hstep = (size_t)HALF * K * 2;
    const size_t tstep = 2 * hstep;
    const unsigned ldsw = (unsigned)wid * 1024u;
    const int aoff = lds_byte(wr * 64 + fr, fq * 8), boff = lds_byte(wc * 32 + fr, fq * 8);
#define PG8_SA(b, h) (((b) * 2 + (h)) * HTB)
#define PG8_SB(b, h) ((4 + (b) * 2 + (h)) * HTB)
#define PG8_STAGE(bufoff, gbase, voff) do { _Pragma("unroll") for (int _i = 0; _i < 2; ++_i) \
        __builtin_amdgcn_global_load_lds((const unsigned*)((const char*)(gbase) + (voff)[_i]), (PG8_LAS unsigned*)(lds + (bufoff) + ldsw + _i * 8192), 16, 0, 0); } while (0)
#define PG8_LDA(dst, b, h) do { _Pragma("unroll") for (int m = 0; m < 4; ++m) _Pragma("unroll") for (int k = 0; k < 2; ++k) dst[m][k] = *(const PG8_LAS bf16x8*)(lds + PG8_SA(b, h) + aoff + m * 2048 + k * 1024); } while (0)
#define PG8_LDB(dst, b, h) do { _Pragma("unroll") for (int n = 0; n < 2; ++n) _Pragma("unroll") for (int k = 0; k < 2; ++k) dst[n][k] = *(const PG8_LAS bf16x8*)(lds + PG8_SB(b, h) + boff + n * 2048 + k * 1024); } while (0)
#define PG8_MMA(ai, bj, At, Bt) do { __builtin_amdgcn_s_setprio(1); _Pragma("unroll") for (int m = 0; m < 4; ++m) _Pragma("unroll") for (int n = 0; n < 2; ++n) _Pragma("unroll") for (int k = 0; k < 2; ++k) \
        acc[ai][bj][m][n] = __builtin_amdgcn_mfma_f32_16x16x32_bf16(Bt[n][k], At[m][k], acc[ai][bj][m][n], 0, 0, 0); __builtin_amdgcn_s_setprio(0); } while (0)
#define PG8_WAIT_V(n) asm volatile("s_waitcnt vmcnt(" #n ")" ::: "memory")
#define PG8_WAIT_L(n) asm volatile("s_waitcnt lgkmcnt(" #n ")" ::: "memory")
#define PG8_BAR __builtin_amdgcn_s_barrier()
#define PG8_SCHED __builtin_amdgcn_sched_barrier(0)
    Unit cur, nxt; int ui = 0;
    if (!S.next(0, cur)) return;
    f32x4 acc[2][2][4][2];
#pragma unroll
    for (int a = 0; a < 2; ++a)
#pragma unroll
        for (int b = 0; b < 2; ++b)
#pragma unroll
            for (int m = 0; m < 4; ++m)
#pragma unroll
                for (int n = 0; n < 2; ++n) acc[a][b][m][n] = (f32x4){0.f, 0.f, 0.f, 0.f};
    bf16x8 At[4][2], B0[2][2], B1[2][2];
    const char* cA = (const char*)g.A + (size_t)cur.pm * tstep; const char* cB = (const char*)g.Bt + (size_t)cur.pn * tstep;
    S.a_ready(cur);
    if constexpr (SP2) {
        PG8_STAGE(PG8_SB(0, 0), cB, voffB); PG8_STAGE(PG8_SB(0, 1), cB + hstep, voffB); PG8_STAGE(PG8_SA(0, 0), cA, voffA); PG8_STAGE(PG8_SA(0, 1), cA + hstep, voffA);
        if (wr == 1) PG8_BAR;
        PG8_WAIT_V(2); PG8_BAR;
        PG8_STAGE(PG8_SB(1, 0), cB + kstep, voffB); PG8_STAGE(PG8_SA(1, 0), cA + kstep, voffA); PG8_STAGE(PG8_SB(1, 1), cB + hstep + kstep, voffB);
        PG8_WAIT_V(6); PG8_BAR;
    } else {
        PG8_STAGE(PG8_SB(0, 0), cB, voffB); PG8_STAGE(PG8_SA(0, 0), cA, voffA); PG8_STAGE(PG8_SB(0, 1), cB + hstep, voffB); PG8_STAGE(PG8_SA(0, 1), cA + hstep, voffA);
        if (wr == 1) PG8_BAR;
        PG8_WAIT_V(4); PG8_BAR;
        PG8_STAGE(PG8_SB(1, 0), cB + kstep, voffB); PG8_STAGE(PG8_SA(1, 0), cA + kstep, voffA); PG8_STAGE(PG8_SB(1, 1), cB + hstep + kstep, voffB);
        PG8_WAIT_V(6); PG8_BAR;
    }
    for (;;) {
        const bool has_next = S.next(ui + 1, nxt);
        const char* nA = has_next ? (const char*)g.A + (size_t)nxt.pm * tstep : cA; const char* nB = has_next ? (const char*)g.Bt + (size_t)nxt.pn * tstep : cB;
        for (int t = 0; t < nt; t += 2) {
            const bool last = (t == nt - 2);
            const char* a1 = cA + (size_t)(t + 1) * kstep;
            const char* a2 = last ? nA : cA + (size_t)(t + 2) * kstep; const char* b2 = last ? nB : cB + (size_t)(t + 2) * kstep;
            const char* a3 = a2 + kstep; const char* b3 = b2 + kstep;
            if (last && has_next) S.a_ready(nxt);
            if constexpr (SP2) {
            PG8_LDB(B0, 0, 0); PG8_LDB(B1, 0, 1); PG8_SCHED; PG8_LDA(At, 0, 0); PG8_STAGE(PG8_SA(1, 1), a1 + hstep, voffA);
            PG8_WAIT_V(8); PG8_WAIT_L(0); PG8_BAR; PG8_MMA(0, 0, At, B0); PG8_MMA(0, 1, At, B1); PG8_BAR; PG8_SCHED;
            PG8_LDA(At, 0, 1); PG8_STAGE(PG8_SB(0, 0), b2, voffB); PG8_STAGE(PG8_SB(0, 1), b2 + hstep, voffB); PG8_STAGE(PG8_SA(0, 0), a2, voffA);
            PG8_WAIT_V(8); PG8_WAIT_L(0); PG8_BAR; PG8_MMA(1, 0, At, B0); PG8_MMA(1, 1, At, B1); PG8_BAR; PG8_SCHED;
            PG8_LDB(B0, 1, 0); PG8_LDB(B1, 1, 1); PG8_SCHED; PG8_LDA(At, 1, 0); PG8_STAGE(PG8_SA(0, 1), a2 + hstep, voffA);
            PG8_WAIT_V(8); PG8_WAIT_L(0); PG8_BAR; PG8_MMA(0, 0, At, B0); PG8_MMA(0, 1, At, B1); PG8_BAR; PG8_SCHED;
            PG8_LDA(At, 1, 1); PG8_STAGE(PG8_SB(1, 0), b3, voffB); PG8_STAGE(PG8_SB(1, 1), b3 + hstep, voffB); PG8_STAGE(PG8_SA(1, 0), a3, voffA);
            PG8_WAIT_V(8); PG8_WAIT_L(0); PG8_BAR; PG8_MMA(1, 0, At, B0); PG8_MMA(1, 1, At, B1); PG8_BAR; PG8_SCHED;
            } else {
            PG8_LDB(B0, 0, 0); PG8_SCHED; PG8_LDA(At, 0, 0); PG8_STAGE(PG8_SA(1, 1), a1 + hstep, voffA);
            PG8_WAIT_L(8); PG8_BAR; PG8_WAIT_L(0); PG8_MMA(0, 0, At, B0); PG8_BAR; PG8_SCHED;
            PG8_LDB(B1, 0, 1); PG8_STAGE(PG8_SB(0, 0), b2, voffB);
            PG8_BAR; PG8_WAIT_L(0); PG8_MMA(0, 1, At, B1); PG8_BAR;
            PG8_LDA(At, 0, 1); PG8_STAGE(PG8_SA(0, 0), a2, voffA);
            PG8_BAR; PG8_WAIT_L(0); PG8_MMA(1, 0, At, B0); PG8_BAR; PG8_SCHED;
            PG8_STAGE(PG8_SB(0, 1), b2 + hstep, voffB);
            PG8_WAIT_V(6); PG8_BAR; PG8_MMA(1, 1, At, B1); PG8_BAR;
            PG8_LDB(B0, 1, 0); PG8_SCHED; PG8_LDA(At, 1, 0); PG8_STAGE(PG8_SA(0, 1), a2 + hstep, voffA);
            PG8_WAIT_L(8); PG8_BAR; PG8_WAIT_L(0); PG8_MMA(0, 0, At, B0); PG8_BAR; PG8_SCHED;
            PG8_LDB(B1, 1, 1); PG8_STAGE(PG8_SB(1, 0), b3, voffB);
            PG8_BAR; PG8_WAIT_L(0); PG8_MMA(0, 1, At, B1); PG8_BAR;
            PG8_LDA(At, 1, 1); PG8_STAGE(PG8_SA(1, 0), a3, voffA);
            PG8_BAR; PG8_WAIT_L(0); PG8_MMA(1, 0, At, B0); PG8_BAR; PG8_SCHED;
            PG8_STAGE(PG8_SB(1, 1), b3 + hstep, voffB);
            PG8_WAIT_V(6); PG8_BAR; PG8_MMA(1, 1, At, B1); PG8_BAR;
            }
        }
        if constexpr (ALIGN_EPI) { if (wr == 0) PG8_BAR; }
        if constexpr (!Epi::AFTER_DRAIN) { int le_ = (int)__builtin_amdgcn_mbcnt_hi(~0u, __builtin_amdgcn_mbcnt_lo(~0u, 0u)); asm volatile("" : "+v"(le_)); E(acc, cur, wr, wc, le_ & 15, le_ >> 4); S.done(cur); }
        if (!has_next) break;
#pragma unroll
        for (int a = 0; a < 2; ++a)
#pragma unroll
            for (int b = 0; b < 2; ++b)
#pragma unroll
                for (int m = 0; m < 4; ++m)
#pragma unroll
                    for (int n = 0; n < 2; ++n) acc[a][b][m][n] = (f32x4){0.f, 0.f, 0.f, 0.f};
        cur = nxt; cA = nA; cB = nB; ++ui;
        if constexpr (ALIGN_EPI) { if (wr == 1) PG8_BAR; }
    }
    PG8_WAIT_V(0);
    if constexpr (!ALIGN_EPI) { if (wr == 0) PG8_BAR; }
    PG8_BAR;
    if constexpr (Epi::AFTER_DRAIN) { int le_ = (int)__builtin_amdgcn_mbcnt_hi(~0u, __builtin_amdgcn_mbcnt_lo(~0u, 0u)); asm volatile("" : "+v"(le_)); E.fused(acc, cur, wr, wc, le_ & 15, le_ >> 4, lds, wid, le_); S.done(cur); }
#undef PG8_SA
#undef PG8_SB
#undef PG8_STAGE
#undef PG8_LDA
#undef PG8_LDB
#undef PG8_MMA
#undef PG8_WAIT_V
#undef PG8_WAIT_L
#undef PG8_BAR
#undef PG8_SCHED
}

constexpr size_t G1_MiB = 1u << 20;
constexpr size_t G1_RS = 20 * G1_MiB, G1_GT = 30 * G1_MiB, G1_Q = 102 * G1_MiB, G1_ZA = 120 * G1_MiB, G1_ZB = 138 * G1_MiB, G1_ZC = 148 * G1_MiB, G1_KWF = 158 * G1_MiB, G1_PIN = 176 * G1_MiB, G1_U = 194 * G1_MiB, G1_V = 212 * G1_MiB, G1_KSB = 362 * G1_MiB, G1_KWB = 372 * G1_MiB;
constexpr size_t G1_O_KC_P = 16908288, G1_O_KC_S = 25296896, G1_O_KS_P = 25362432, G1_O_KS_S = 33751040, G1_O_KW_P = 33816576, G1_O_KW_S = 34865152, G1_O_PL_P = 68419584, G1_O_PL_S = 68450304;
constexpr int E_MP = 16384, E_MR = 16512, E_SEQ = 4096, G1_MPAD = 16640;
constexpr size_t G1_XB = 34 * G1_MiB, G1_XS = 230 * G1_MiB;
constexpr int CW_SEAM = 8192;
constexpr float QSCALE = 0.125f * 1.4426950408889634f;
__device__ __forceinline__ float sigmoidf_(float x) { return __builtin_amdgcn_rcpf(1.f + __builtin_amdgcn_exp2f(-1.4426950408889634f * x)); }
__device__ __forceinline__ u32x4 pack8(f32x4 a, f32x4 b) { u32x4 w; w.x = cvt_pk_bf16(a[0], a[1]); w.y = cvt_pk_bf16(a[2], a[3]); w.z = cvt_pk_bf16(b[0], b[1]); w.w = cvt_pk_bf16(b[2], b[3]); return w; }
__device__ __forceinline__ f32x4 silu4(f32x4 v) { f32x4 r; r[0] = v[0] * sigmoidf_(v[0]); r[1] = v[1] * sigmoidf_(v[1]); r[2] = v[2] * sigmoidf_(v[2]); r[3] = v[3] * sigmoidf_(v[3]); return r; }

struct EpiG1 {
    static constexpr bool PERM = true, AFTER_DRAIN = false;
    unsigned char* ws; float* out; int l;
    template <int KIND> __device__ __forceinline__ void tile(const f32x4 (&acc)[2][2][4][2], const Unit& u, int wr, int wc, int fr, int fq) const {
        const int row0 = u.pm * BM + wr * 64 + fr;
        const float* RS = (const float*)(ws + G1_RS); bf16_t* Q = (bf16_t*)(ws + G1_Q); float* KWF = (float*)(ws + G1_KWF); bf16_t* ZA = (bf16_t*)(ws + G1_ZA); float* PIN = (float*)(ws + G1_PIN);
        bf16_t* ZB = (bf16_t*)(ws + G1_ZB); float* U = (float*)(ws + G1_U); float* V = (float*)(ws + G1_V); bf16_t* ZC = (bf16_t*)(ws + G1_ZC); float* GT = (float*)(ws + G1_GT);
        float* kc_p = out + G1_O_KC_P + (size_t)l * E_MP * 256; float* kc_s = out + G1_O_KC_S + (size_t)l * 128 * 256; float* ks_p = out + G1_O_KS_P + (size_t)l * E_MP * 256; float* ks_s = out + G1_O_KS_S + (size_t)l * 128 * 256;
        float* kw_p = out + G1_O_KW_P + (size_t)l * 4 * 512 * 256; float* kw_s = out + G1_O_KW_S + (size_t)l * 128 * 512 * 256; float* pool_p = out + G1_O_PL_P + (size_t)l * 4 * 15 * 256; float* pool_s = out + G1_O_PL_S + (size_t)l * 128 * 15 * 256;
        float ssq[2][4];
#pragma unroll
        for (int ai = 0; ai < 2; ++ai)
#pragma unroll
            for (int m = 0; m < 4; ++m) ssq[ai][m] = RS[(size_t)l * G1_MPAD + row0 + ai * HALF + m * 16];
#pragma unroll
        for (int ai = 0; ai < 2; ++ai)
#pragma unroll
            for (int m = 0; m < 4; ++m) {
                const int row = row0 + ai * HALF + m * 16;
                if (row < E_MR) {
                    const float rs = 1.f / sqrtf(ssq[ai][m] * (1.f / 1024.f) + 1e-6f);
                    const bool isP = row < E_MP; const int b = row >> 12, t = row & (E_SEQ - 1), sb = row - E_MP;
#pragma unroll
                    for (int bj = 0; bj < 2; ++bj) {
                        const int col = wc * 32 + 8 * fq + bj * HALF;
                        f32x4 v0 = acc[ai][bj][m][0] * rs, v1 = acc[ai][bj][m][1] * rs;
                        if constexpr (KIND == 0) {
                            *(u32x4*)(Q + (size_t)row * 512 + u.pn * 256 + col) = pack8(v0 * QSCALE, v1 * QSCALE);
                        } else if constexpr (KIND == 1) {
                            float* d = isP ? kc_p + (size_t)row * 256 : kc_s + (size_t)sb * 256; *(f32x4*)(d + col) = v0; *(f32x4*)(d + col + 4) = v1;
                        } else if constexpr (KIND == 2) {
                            float* d = isP ? ks_p + (size_t)row * 256 : ks_s + (size_t)sb * 256; __builtin_nontemporal_store(v0, (f32x4*)(d + col)); __builtin_nontemporal_store(v1, (f32x4*)(d + col + 4));
                            *(u32x4*)((bf16_t*)(ws + G1_KSB) + (size_t)row * 256 + col) = pack8(v0, v1);
                        } else if constexpr (KIND == 3) {
                            *(u32x4*)((bf16_t*)(ws + G1_KWB) + (size_t)row * 256 + col) = pack8(v0, v1);
                            float* e = nullptr;
                            if (isP) { if (t >= E_SEQ - 512) e = kw_p + ((size_t)b * 512 + (t - (E_SEQ - 512))) * 256; } else e = kw_s + ((size_t)sb * 512 + 511) * 256;
                            if (e) { *(f32x4*)(e + col) = v0; *(f32x4*)(e + col + 4) = v1; }
                        } else if constexpr (KIND == 4) {
                            *(u32x4*)(ZA + (size_t)row * 512 + (u.pn - 5) * 256 + col) = pack8(silu4(v0), silu4(v1));
                        } else if constexpr (KIND == 5) {
                            float* d = PIN + (size_t)row * 256; *(f32x4*)(d + col) = v0; *(f32x4*)(d + col + 4) = v1;
                            float* e = nullptr;
                            if (isP) { if (t >= E_SEQ - 15) e = pool_p + ((size_t)b * 15 + (t - (E_SEQ - 15))) * 256; } else e = pool_s + ((size_t)sb * 15 + 14) * 256;
                            if (e) { *(f32x4*)(e + col) = v0; *(f32x4*)(e + col + 4) = v1; }
                        } else if constexpr (KIND == 6) {
                            *(u32x4*)(ZB + (size_t)row * 256 + col) = pack8(silu4(v0), silu4(v1));
                        } else if constexpr (KIND == 7) {
                            float* d = U + (size_t)row * 256; *(f32x4*)(d + col) = v0; *(f32x4*)(d + col + 4) = v1;
                        } else if constexpr (KIND == 8) {
                            float* d = V + (size_t)row * 256; *(f32x4*)(d + col) = v0; *(f32x4*)(d + col + 4) = v1;
                        } else if constexpr (KIND == 9) {
                            *(u32x4*)(ZC + (size_t)row * 256 + col) = pack8(silu4(v0), silu4(v1));
                        } else {
                            if (col < 24) { float* d = GT + (size_t)row * 32 + col; f32x4 g0, g1;
                                for (int i = 0; i < 4; ++i) { g0[i] = sigmoidf_(v0[i]); g1[i] = sigmoidf_(v1[i]); }
                                *(f32x4*)d = g0; *(f32x4*)(d + 4) = g1; }
                        }
                    }
                }
            }
    }
    __device__ __forceinline__ void operator()(const f32x4 (&acc)[2][2][4][2], const Unit& u, int wr, int wc, int fr, int fq) const {
        asm volatile("" : "+v"(fr), "+v"(fq));
        switch (u.pn) {
            case 0: case 1: tile<0>(acc, u, wr, wc, fr, fq); break;
            case 2: tile<1>(acc, u, wr, wc, fr, fq); break;
            case 3: tile<2>(acc, u, wr, wc, fr, fq); break;
            case 4: tile<3>(acc, u, wr, wc, fr, fq); break;
            case 5: case 6: tile<4>(acc, u, wr, wc, fr, fq); break;
            case 7: tile<5>(acc, u, wr, wc, fr, fq); break;
            case 8: tile<6>(acc, u, wr, wc, fr, fq); break;
            case 9: tile<7>(acc, u, wr, wc, fr, fq); break;
            case 10: tile<8>(acc, u, wr, wc, fr, fq); break;
            case 11: tile<9>(acc, u, wr, wc, fr, fq); break;
            default: tile<10>(acc, u, wr, wc, fr, fq); break;
        }
    }
};
struct EpiG2 {
    static constexpr bool PERM = true, AFTER_DRAIN = false;
    bf16_t* O;
    __device__ __forceinline__ void operator()(const f32x4 (&acc)[2][2][4][2], const Unit& u, int wr, int wc, int fr, int fq) const {
        asm volatile("" : "+v"(fr), "+v"(fq));
        const int row0 = u.pm * BM + wr * 64 + fr;
#pragma unroll
        for (int ai = 0; ai < 2; ++ai)
#pragma unroll
            for (int m = 0; m < 4; ++m) {
                const int row = row0 + ai * HALF + m * 16;
                if (row < E_MR) {
#pragma unroll
                    for (int bj = 0; bj < 2; ++bj) { bf16_t* d = O + (size_t)row * 1024 + u.pn * BM + wc * 32 + 8 * fq + bj * HALF; *(u32x4*)d = pack8(acc[ai][bj][m][0], acc[ai][bj][m][1]); }
                }
            }
    }
};
struct EpiG2F {
    static constexpr bool PERM = true, AFTER_DRAIN = true;
    unsigned char* ws; float* out; const float* xin; const float* gpost; unsigned* ctl; int l;
    __device__ __forceinline__ void fused(f32x4 (&acc)[2][2][4][2], const Unit& u, int wr, int wc, int fr, int fq, PG8_LAS unsigned char* lds, int wid, int lane) const {
        u32x4 preb[4][2];
        { bf16_t* XBp = (bf16_t*)(ws + G1_XB);
#pragma unroll
          for (int m = 0; m < 4; ++m) { const size_t row = (size_t)u.pm * BM + wr * 64 + m * 16 + fr;
#pragma unroll
              for (int bj = 0; bj < 2; ++bj) { const int col = u.pn * BM + wc * 32 + 8 * fq + bj * HALF;
                  preb[m][bj] = *(const u32x4*)(XBp + row * 1024 + col); } } }
        PG8_LAS float* P = (PG8_LAS float*)lds;
        PG8_LAS float* S = P + 1024;
        PG8_LAS unsigned* flag = (PG8_LAS unsigned*)(S + 256);
        const int tid = wid * 64 + lane;
#pragma unroll
        for (int ai = 0; ai < 2; ++ai)
#pragma unroll
            for (int m = 0; m < 4; ++m) { float s = 0.f;
#pragma unroll
                for (int bj = 0; bj < 2; ++bj)
#pragma unroll
                    for (int n = 0; n < 2; ++n) { const f32x4 x = acc[ai][bj][m][n]; s += (x[0] * x[0] + x[1] * x[1]) + (x[2] * x[2] + x[3] * x[3]); }
                s += __builtin_bit_cast(float, __builtin_amdgcn_ds_swizzle(__builtin_bit_cast(int, s), 0x401F));
                { auto rr = __builtin_amdgcn_permlane32_swap(__float_as_uint(s), __float_as_uint(s), false, false); s = __uint_as_float(rr[0]) + __uint_as_float(rr[1]); }
                if (fq == 0) P[(ai * HALF + wr * 64 + m * 16 + fr) * 4 + wc] = s; }
        asm volatile("s_waitcnt lgkmcnt(0)" ::: "memory"); __builtin_amdgcn_s_barrier(); asm volatile("" ::: "memory");
        float* slots = (float*)(ws + G1_XS) + (size_t)l * E_MP * 4;
        unsigned* cnt = ctl + CW_SEAM + (l * 65 + u.pm) * 64;
        if (tid < 256) { const float st = (P[tid * 4] + P[tid * 4 + 1]) + (P[tid * 4 + 2] + P[tid * 4 + 3]);
            __hip_atomic_store(slots + (size_t)(u.pm * BM + tid) * 4 + u.pn, st, __ATOMIC_RELAXED, __HIP_MEMORY_SCOPE_AGENT); }
        asm volatile("s_waitcnt vmcnt(0)" ::: "memory"); __builtin_amdgcn_s_barrier(); asm volatile("" ::: "memory");
        if (tid == 0) __hip_atomic_fetch_add(cnt, 1u, __ATOMIC_RELAXED, __HIP_MEMORY_SCOPE_AGENT);
        if (wid == 0) { bool dead = false; unsigned sp = 0;
            while ((unsigned)__builtin_amdgcn_readfirstlane(__hip_atomic_load(cnt, __ATOMIC_RELAXED, __HIP_MEMORY_SCOPE_AGENT)) < 4u) { __builtin_amdgcn_s_sleep(2); if (++sp > (1u << 16)) { dead = true; break; } }
            __builtin_amdgcn_fence(__ATOMIC_ACQUIRE, "agent");
            if (lane == 0) flag[0] = dead ? 1u : 0u; }
        asm volatile("s_waitcnt vmcnt(0) lgkmcnt(0)" ::: "memory"); __builtin_amdgcn_s_barrier(); asm volatile("" ::: "memory");
        if (tid < 256) { const float* sl = slots + (size_t)(u.pm * BM + tid) * 4; float ss = 0.f;
#pragma unroll
            for (int t = 0; t < 4; ++t) ss += __hip_atomic_load(sl + t, __ATOMIC_RELAXED, __HIP_MEMORY_SCOPE_AGENT);
            S[tid] = flag[0] ? __builtin_nanf("") : 1.f / sqrtf(ss * (1.f / 1024.f) + 1e-6f); }
        asm volatile("s_waitcnt vmcnt(0) lgkmcnt(0)" ::: "memory"); __builtin_amdgcn_s_barrier(); asm volatile("" ::: "memory");
        bf16_t* XB = (bf16_t*)(ws + G1_XB); float* RSN = (float*)(ws + G1_RS) + G1_MPAD;
        f32x4 gq[2][2];
#pragma unroll
        for (int bj = 0; bj < 2; ++bj) { const int col = u.pn * BM + wc * 32 + 8 * fq + bj * HALF; gq[bj][0] = *(const f32x4*)(gpost + col); gq[bj][1] = *(const f32x4*)(gpost + col + 4); }
#pragma unroll
        for (int ai = 0; ai < 2; ++ai) {
            if (ai == 1) {
#pragma unroll
                for (int m = 0; m < 4; ++m) { const size_t row = (size_t)u.pm * BM + HALF + wr * 64 + m * 16 + fr;
#pragma unroll
                    for (int bj = 0; bj < 2; ++bj) { const int col = u.pn * BM + wc * 32 + 8 * fq + bj * HALF; preb[m][bj] = *(const u32x4*)(XB + row * 1024 + col); } }
                __builtin_amdgcn_sched_barrier(0);
            }
#pragma unroll
            for (int m = 0; m < 4; ++m) { const int rl = ai * HALF + wr * 64 + m * 16 + fr; const size_t row = (size_t)u.pm * BM + rl; const float r = S[rl]; float q = 0.f;
#pragma unroll
                for (int bj = 0; bj < 2; ++bj) { const int col = u.pn * BM + wc * 32 + 8 * fq + bj * HALF;
                    const f32x4 g0 = gq[bj][0], g1 = gq[bj][1]; f32x4 x0, x1;
                    { const u32x4 w = preb[m][bj];
                        x0 = (f32x4){__uint_as_float(w.x << 16), __uint_as_float(w.x & 0xffff0000u), __uint_as_float(w.y << 16), __uint_as_float(w.y & 0xffff0000u)};
                        x1 = (f32x4){__uint_as_float(w.z << 16), __uint_as_float(w.z & 0xffff0000u), __uint_as_float(w.w << 16), __uint_as_float(w.w & 0xffff0000u)}; }
                    const f32x4 y0 = x0 + acc[ai][bj][m][0] * r * g0, y1 = x1 + acc[ai][bj][m][1] * r * g1;
                    if (l == 0) { *(u32x4*)(XB + row * 1024 + col) = pack8(y0, y1);
                        q += ((y0[0] * y0[0] + y0[1] * y0[1]) + (y0[2] * y0[2] + y0[3] * y0[3])) + ((y1[0] * y1[0] + y1[1] * y1[1]) + (y1[2] * y1[2] + y1[3] * y1[3])); }
                    else { float* d = out + row * 1024 + col; __builtin_nontemporal_store(y0, (f32x4*)d); __builtin_nontemporal_store(y1, (f32x4*)(d + 4)); } }
                if (l == 0) { q += __builtin_bit_cast(float, __builtin_amdgcn_ds_swizzle(__builtin_bit_cast(int, q), 0x401F));
                    { auto rr = __builtin_amdgcn_permlane32_swap(__float_as_uint(q), __float_as_uint(q), false, false); q = __uint_as_float(rr[0]) + __uint_as_float(rr[1]); }
                    if (fq == 0) __hip_atomic_fetch_add(RSN + row, q, __ATOMIC_RELAXED, __HIP_MEMORY_SCOPE_AGENT); } }
        }
    }
};
}

constexpr int NWAVES = 8;
constexpr int DM = 1024, NB = 4, SEQ = 4096, DEPTH = 2, DECB = 128, PAST = 2048, PAGE = 128, NPAGES = PAST / PAGE, NPHYS = 2560;
constexpr int MP = NB * SEQ, MR = MP + DECB, MPAD = 16640;
constexpr int DIN = 3096, N1 = 3328;
constexpr int WINDOW = 512, POOLR = 15, CHUNK = 128;
constexpr float EPS = 1e-6f, LOG2E = 1.4426950408889634f;
static_assert(MP == pg8::E_MP && MR == pg8::E_MR && SEQ == pg8::E_SEQ, "epilogue constants");
constexpr int NPHASES = 11;
#ifndef MK_N_LAUNCHES
#define MK_N_LAUNCHES 1
#endif
constexpr int N_LAUNCHES = MK_N_LAUNCHES;
static_assert(N_LAUNCHES == 1 || N_LAUNCHES == NPHASES, "launch cuts");

constexpr size_t O_Y_P = 0, O_Y_S = O_Y_P + (size_t)MP * DM, O_KC_P = O_Y_S + (size_t)DECB * DM, O_KC_S = O_KC_P + (size_t)DEPTH * MP * 256,
    O_KS_P = O_KC_S + (size_t)DEPTH * DECB * 256, O_KS_S = O_KS_P + (size_t)DEPTH * MP * 256, O_KW_P = O_KS_S + (size_t)DEPTH * DECB * 256,
    O_KW_S = O_KW_P + (size_t)DEPTH * NB * 512 * 256, O_PL_P = O_KW_S + (size_t)DEPTH * DECB * 512 * 256, O_PL_S = O_PL_P + (size_t)DEPTH * NB * 15 * 256,
    O_GV_P = O_PL_S + (size_t)DEPTH * DECB * 15 * 256, O_GV_S = O_GV_P + (size_t)DEPTH * NB * 128 * 256, O_END = O_GV_S + (size_t)DEPTH * DECB * 256;
static_assert(O_END == 69761024, "output size");
static_assert(O_KC_P == pg8::G1_O_KC_P && O_KC_S == pg8::G1_O_KC_S && O_KS_P == pg8::G1_O_KS_P && O_KS_S == pg8::G1_O_KS_S && O_KW_P == pg8::G1_O_KW_P && O_KW_S == pg8::G1_O_KW_S && O_PL_P == pg8::G1_O_PL_P && O_PL_S == pg8::G1_O_PL_S, "epilogue output offsets");

constexpr size_t MiB = 1u << 20;
constexpr size_t WS_CTL = 0, CTL_ZERO_BYTES = 128 * 1024;
constexpr size_t WS_W1T = 2 * MiB;
constexpr size_t WS_W2T = 16 * MiB;
constexpr size_t WS_RS = 20 * MiB;
constexpr size_t WS_KCP = 21 * MiB;
constexpr size_t WS_KCS = 22 * MiB;
constexpr size_t WS_GT = 30 * MiB;
constexpr size_t WS_XB = 34 * MiB;
constexpr size_t WS_MIX = 68 * MiB;
constexpr size_t WS_Q = 102 * MiB;
constexpr size_t WS_ZA = 120 * MiB;
constexpr size_t WS_ZB = 138 * MiB;
constexpr size_t WS_ZC = 148 * MiB;
constexpr size_t WS_KWF = 158 * MiB;
constexpr size_t WS_PIN = 176 * MiB;
constexpr size_t WS_U = 194 * MiB;
constexpr size_t WS_V = 212 * MiB;
constexpr size_t WS_XF = 230 * MiB;
constexpr size_t WS_OUTF = 296 * MiB;
constexpr size_t WS_KSB = 362 * MiB;
constexpr size_t WS_KWB = 372 * MiB;
constexpr size_t WS_WGB = 382 * MiB;
constexpr size_t WS_END = 384 * MiB;
static_assert(WS_XB == pg8::G1_XB && WS_XF == pg8::G1_XS && MPAD == pg8::G1_MPAD && (pg8::CW_SEAM + 142 * 64) * 4 <= (int)CTL_ZERO_BYTES && WS_RS == pg8::G1_RS && WS_GT == pg8::G1_GT && WS_Q == pg8::G1_Q && WS_ZA == pg8::G1_ZA && WS_ZB == pg8::G1_ZB && WS_ZC == pg8::G1_ZC && WS_KWF == pg8::G1_KWF && WS_PIN == pg8::G1_PIN && WS_U == pg8::G1_U && WS_V == pg8::G1_V && WS_KSB == pg8::G1_KSB && WS_KWB == pg8::G1_KWB, "epilogue workspace offsets");
constexpr int CW_BAR = 4096;

constexpr int RING_OFF = 0, RING_BYTES = 131072;
constexpr int LDSCTL_OFF = RING_BYTES, MISC_OFF = LDSCTL_OFF + 320;
constexpr int LDS_BYTES = 147456;

#define GAS __attribute__((address_space(1)))
#define LAS __attribute__((address_space(3)))
typedef unsigned short bf16;
typedef unsigned v4u __attribute__((ext_vector_type(4)));
typedef unsigned v2u __attribute__((ext_vector_type(2)));
typedef float f32x4 __attribute__((ext_vector_type(4)));
typedef GAS unsigned gu32;
#define RLX_AGENT __ATOMIC_RELAXED, __HIP_MEMORY_SCOPE_AGENT
#define LDS_WAIT() asm volatile("s_waitcnt lgkmcnt(0)" ::: "memory")
#define VM_WAIT() asm volatile("s_waitcnt vmcnt(0)" ::: "memory")
typedef __bf16 hw_bf16x2 __attribute__((ext_vector_type(2)));
typedef float hw_f32x2 __attribute__((ext_vector_type(2)));
__device__ __forceinline__ unsigned pk2(float lo, float hi) { hw_f32x2 v = {lo, hi}; hw_bf16x2 b = __builtin_convertvector(v, hw_bf16x2); return __builtin_bit_cast(unsigned, b); }
__device__ __forceinline__ unsigned f2bf(float f) { return pk2(f, 0.f) & 0xffffu; }
__device__ __forceinline__ float bf2f(unsigned short h) { return __builtin_bit_cast(float, (unsigned)h << 16); }
__device__ __forceinline__ int lane_l() { int l = (int)__builtin_amdgcn_mbcnt_hi(~0u, __builtin_amdgcn_mbcnt_lo(~0u, 0u)); asm volatile("" : "+v"(l)); return l; }
__device__ __forceinline__ float shx(float v, int idx4) { return __builtin_bit_cast(float, __builtin_amdgcn_ds_bpermute(idx4, __builtin_bit_cast(int, v))); }
__device__ __forceinline__ unsigned shxu(unsigned v, int idx4) { return (unsigned)__builtin_amdgcn_ds_bpermute(idx4, (int)v); }
template <int CTRL> __device__ __forceinline__ float dppf(float v) { return __builtin_bit_cast(float, __builtin_amdgcn_update_dpp(0, __builtin_bit_cast(int, v), CTRL, 0xF, 0xF, true)); }
__device__ __forceinline__ float swz16(float v) { return __builtin_bit_cast(float, __builtin_amdgcn_ds_swizzle(__builtin_bit_cast(int, v), 0x401F)); }
__device__ __forceinline__ float wave_sum(float v) {
    v += dppf<0xB1>(v); v += dppf<0x4E>(v); v += dppf<0x141>(v); v += dppf<0x140>(v); v += swz16(v);
    auto rr = __builtin_amdgcn_permlane32_swap(__float_as_uint(v), __float_as_uint(v), false, false); return __uint_as_float(rr[0]) + __uint_as_float(rr[1]);
}
__device__ __forceinline__ float wave_max(float v) {
    v = fmaxf(v, dppf<0xB1>(v)); v = fmaxf(v, dppf<0x4E>(v)); v = fmaxf(v, dppf<0x141>(v)); v = fmaxf(v, dppf<0x140>(v)); v = fmaxf(v, swz16(v));
    auto rr = __builtin_amdgcn_permlane32_swap(__float_as_uint(v), __float_as_uint(v), false, false); return fmaxf(__uint_as_float(rr[0]), __uint_as_float(rr[1]));
}
__device__ __forceinline__ float rdlane(float v, int i) { return __builtin_bit_cast(float, __builtin_amdgcn_readlane(__builtin_bit_cast(int, v), i)); }
__device__ __forceinline__ float siluf_(float x) { return x * __builtin_amdgcn_rcpf(1.f + __builtin_amdgcn_exp2f(-1.4426950408889634f * x)); }

#define XB_TMO      128
#define XB_XCNT(j)  (256  + 64 * (j))
#define XB_XSUB(j)  (1280 + 64 * (j))
#define XB_XGEN(j)  (2304 + 64 * (j))
#define XB_TOP      3328
#define XB_TOPGEN   3392
#define XCD_BAR_WORDS 3456
#define XB_SPIN_CAP (1u << 18)

__device__ __forceinline__ unsigned xb_ld(unsigned* p)              { return __hip_atomic_load(p, __ATOMIC_RELAXED, __HIP_MEMORY_SCOPE_AGENT); }
__device__ __forceinline__ unsigned xb_add(unsigned* p, unsigned v) { return __hip_atomic_fetch_add(p, v, __ATOMIC_RELAXED, __HIP_MEMORY_SCOPE_AGENT); }
__device__ __forceinline__ unsigned xb_xcc_id() { return (unsigned)__builtin_amdgcn_s_getreg((3 << 11) | 20) & 0xFu; }
#define XB_SPIN(cond, bar) do { unsigned _sp = 0; while (cond) { __builtin_amdgcn_s_sleep(1); \
    if ((++_sp & 255u) == 0u) { if (xb_ld(&(bar)[XB_TMO])) break; if (_sp > XB_SPIN_CAP) { atomicAdd(&(bar)[XB_TMO], 1u); break; } } } } while (0)

struct XcdBarrier {
    unsigned* bar; unsigned x;
    volatile LAS unsigned* st;
};

__device__ __forceinline__ bool xb_thread0(int wave) { unsigned ln = __builtin_amdgcn_mbcnt_hi(~0u, __builtin_amdgcn_mbcnt_lo(~0u, 0u)); asm volatile("" : "+v"(ln)); return wave == 0 && ln == 0u; }
__device__ __forceinline__ XcdBarrier xcd_barrier_post(unsigned* bar, volatile LAS unsigned* st, int wave) {
    XcdBarrier b; b.bar = bar; b.x = xb_xcc_id(); b.st = st;
    if (xb_thread0(wave)) (void)xb_add(&bar[XB_XCNT(b.x)], 1u);
    return b;
}
__device__ __forceinline__ void xcd_barrier_complete(unsigned* bar, unsigned x, unsigned& nloc, unsigned& nx) {
    const unsigned G = gridDim.x * gridDim.y * gridDim.z;
    unsigned sum, cnt, mine, sp = 0u;
    for (;;) {
        sum = 0u; cnt = 0u; mine = 0u;
#pragma unroll
        for (unsigned j = 0; j < 16; ++j) { const unsigned c = xb_ld(&bar[XB_XCNT(j)]); sum += c; cnt += (c > 0u) ? 1u : 0u; mine = (j == x) ? c : mine; }
        if (sum == G) break;
        __builtin_amdgcn_s_sleep(1);
        if ((++sp & 255u) == 0u) { if (xb_ld(&bar[XB_TMO])) break; if (sp > XB_SPIN_CAP) { atomicAdd(&bar[XB_TMO], 1u); break; } }
    }
    nloc = mine > 0u ? mine : 1u; nx = cnt > 0u ? cnt : 1u;
}

__device__ __forceinline__ void xcd_barrier(const XcdBarrier& b, int wave) {
    asm volatile("s_waitcnt vmcnt(0)" ::: "memory");
    __syncthreads();
    if (xb_thread0(wave)) {
        unsigned* bar = b.bar; asm volatile("" : "+s"(bar));
        __builtin_amdgcn_s_waitcnt(0);
        unsigned nloc = b.st[0], nx = b.st[1];
        if (nloc == 0u) { xcd_barrier_complete(bar, b.x, nloc, nx); b.st[0] = nloc; b.st[1] = nx; }
        const unsigned old = xb_add(&bar[XB_XSUB(b.x)], 1u);
        const unsigned gen = old / nloc;
        if (old + 1u == (gen + 1u) * nloc) {
            __builtin_amdgcn_fence(__ATOMIC_RELEASE, "agent");
            asm volatile("s_waitcnt vmcnt(0)" ::: "memory");
            const unsigned og = xb_add(&bar[XB_TOP], 1u);
            const unsigned tg = og / nx;
            if (og + 1u == (tg + 1u) * nx) xb_add(&bar[XB_TOPGEN], 1u);
            else XB_SPIN(xb_ld(&bar[XB_TOPGEN]) == tg, bar);
            __builtin_amdgcn_fence(__ATOMIC_ACQUIRE, "agent");
            xb_add(&bar[XB_XGEN(b.x)], 1u);
            asm volatile("s_waitcnt vmcnt(0)" ::: "memory");
        } else {
            XB_SPIN(xb_ld(&bar[XB_XGEN(b.x)]) == gen, bar);
            __builtin_amdgcn_fence(__ATOMIC_ACQUIRE, "agent");
            asm volatile("s_waitcnt vmcnt(0)" ::: "memory");
        }
    }
    __syncthreads();
}

struct Args { const void* in[19]; float* out; unsigned char* ws; int ph_lo, ph_hi; };
typedef const __attribute__((address_space(4))) struct Args* kargs_t;
struct Frame {
    LAS unsigned char* lds;
    volatile LAS unsigned* MISC;
    gu32* ctl;
    int tid, lane, wave, vcu, G;
};

__device__ __forceinline__ void transpose_item(const float* W, int Nsrc, int k0, int n_src0, int n_valid, const float* gk, bf16* WT, int dst_row0, int K, LAS float* scr, int lane) {
#pragma unroll 8
    for (int i = 0; i < 32; ++i) { const int kk = 2 * i + (lane >> 5), c = lane & 31;
        float w = (c < n_valid) ? W[(size_t)(k0 + kk) * Nsrc + n_src0 + c] : 0.f; if (gk) w *= gk[k0 + kk];
        scr[kk * 33 + c] = w; }
    LDS_WAIT(); asm volatile("" ::: "memory");
    const int c = lane & 7;
#pragma unroll
    for (int j = 0; j < 4; ++j) { const int n = (lane >> 3) + 8 * j; const LAS float* s = scr + (8 * c) * 33 + n;
        v4u o; o.x = pk2(s[0 * 33], s[1 * 33]); o.y = pk2(s[2 * 33], s[3 * 33]); o.z = pk2(s[4 * 33], s[5 * 33]); o.w = pk2(s[6 * 33], s[7 * 33]);
        *(v4u*)(WT + (size_t)(dst_row0 + n) * K + k0 + 8 * c) = o; }
    LDS_WAIT(); asm volatile("" ::: "memory");
}
__device__ __forceinline__ void row_to_bf16(const float* xrow, bf16* orow, float* rs, int lane) {
    const f32x4* xr = (const f32x4*)xrow + lane;
    f32x4 v[4]; float s = 0.f;
#pragma unroll
    for (int j = 0; j < 4; ++j) { v[j] = xr[64 * j]; s += (v[j].x * v[j].x + v[j].y * v[j].y) + (v[j].z * v[j].z + v[j].w * v[j].w); }
    s = wave_sum(s);
    v2u* o8 = (v2u*)orow + lane;
#pragma unroll
    for (int j = 0; j < 4; ++j) { v2u w; w.x = pk2(v[j].x, v[j].y); w.y = pk2(v[j].z, v[j].w); o8[64 * j] = w; }
    if (lane == 0) *rs = 1.f / sqrtf(s * (1.f / DM) + EPS);
}
__device__ __forceinline__ float jq_max(float v) { v = fmaxf(v, swz16(v)); auto rr = __builtin_amdgcn_permlane32_swap(__float_as_uint(v), __float_as_uint(v), false, false); return fmaxf(__uint_as_float(rr[0]), __uint_as_float(rr[1])); }
__device__ __forceinline__ float jq_sum(float v) { v += swz16(v); auto rr = __builtin_amdgcn_permlane32_swap(__float_as_uint(v), __float_as_uint(v), false, false); return __uint_as_float(rr[0]) + __uint_as_float(rr[1]); }
template <int NHALF, bool KEEP_P>
__device__ __forceinline__ void seg3(const f32x4 (&qr)[4], const float* base, int count, int pos0, int pstep, int t, int lo_pos, const float (&slope)[4], int lane  ,
                                     float (&m)[4], float (&l)[4], f32x4 (&o)[4], float (&pk)[8][4]) {
    asm volatile("" : "+v"(lane));
    const int d4 = lane & 15, jq = lane >> 4;
#pragma unroll
    for (int hf = 0; hf < NHALF; ++hf) {
        f32x4 kv[1][8], vv[1][8];
#pragma unroll
        for (int i = 0; i < 8; ++i) { const int j = 4 * (8 * hf + i) + jq; const float* rp = base + (size_t)(j < count ? j : 0) * 256 + 4 * d4;
            kv[0][i] = __builtin_nontemporal_load((const f32x4*)rp); vv[0][i] = __builtin_nontemporal_load((const f32x4*)(rp + 128)); }
        __builtin_amdgcn_sched_barrier(0);
        float s[8][4];
#pragma unroll
        for (int i = 0; i < 8; ++i) { const int j = 4 * (8 * hf + i) + jq, pos = pos0 + j * pstep; const bool valid = (j < count) && (pos <= t) && (pos >= lo_pos); const float dist = (float)(t - pos);
#pragma unroll
            for (int h = 0; h < 4; ++h) { const f32x4 a = kv[0][i], q = qr[h]; float dd = (a.x * q.x + a.y * q.y) + (a.z * q.z + a.w * q.w);
                dd += dppf<0xB1>(dd); dd += dppf<0x4E>(dd); dd += dppf<0x141>(dd); dd += dppf<0x140>(dd);
                s[i][h] = valid ? dd - slope[h] * dist : -1e30f; } }
#pragma unroll
        for (int h = 0; h < 4; ++h) { float mx = s[0][h];
#pragma unroll
            for (int i = 1; i < 8; ++i) mx = fmaxf(mx, s[i][h]);
            mx = jq_max(mx);
            const float mn = fmaxf(m[h], mx), alpha = __builtin_amdgcn_exp2f(m[h] - mn); float ls = 0.f; f32x4 acc = o[h] * alpha;
#pragma unroll
            for (int i = 0; i < 8; ++i) { const float p = s[i][h] > -1e29f ? __builtin_amdgcn_exp2f(s[i][h] - mn) : 0.f; ls += p; acc = acc + vv[0][i] * p; if (KEEP_P && hf == 0) pk[i][h] = p; }
            l[h] = l[h] * alpha + ls; o[h] = acc; m[h] = mn; }
        __builtin_amdgcn_sched_barrier(0);
    }
}
__device__ __forceinline__ f32x4 red_jq(f32x4 v, int lane) {
    const int a = (lane ^ 16) << 2, b = (lane ^ 32) << 2;
    v.x += shx(v.x, a); v.y += shx(v.y, a); v.z += shx(v.z, a); v.w += shx(v.w, a);
    v.x += shx(v.x, b); v.y += shx(v.y, b); v.z += shx(v.z, b); v.w += shx(v.w, b);
    return v;
}
__device__ __forceinline__ void seg_one(const f32x4 (&qr)[4], const f32x4 kx, const f32x4 vx, const float (&slope)[4], float dist, int lane, float (&m)[4], float (&l)[4], f32x4 (&o)[4]) {
    asm volatile("" : "+v"(lane));
    const int jq = lane >> 4;
#pragma unroll
    for (int h = 0; h < 4; ++h) { const f32x4 q = qr[h]; float dd = (kx.x * q.x + kx.y * q.y) + (kx.z * q.z + kx.w * q.w);
        dd += dppf<0xB1>(dd); dd += dppf<0x4E>(dd); dd += dppf<0x141>(dd); dd += dppf<0x140>(dd);
        const float s = jq == 0 ? dd - slope[h] * dist : -1e30f;
        const float mx = jq_max(s), mn = fmaxf(m[h], mx), alpha = __builtin_amdgcn_exp2f(m[h] - mn);
        const float p = s > -1e29f ? __builtin_amdgcn_exp2f(s - mn) : 0.f;
        l[h] = l[h] * alpha + p; o[h] = o[h] * alpha + vx * p; m[h] = mn; }
}
struct AttnPtrs { const bf16* Q; const float* GT; const float* KCS; const float* ks_s; const float* KWF; const float* cache_sel; const float* cache_win; const int* page_table; const bf16* ZA; bf16* MIX; unsigned* cnt; };
__device__ __forceinline__ void sample_unit(const AttnPtrs& A, int l, int sb, int kvh, LAS float* L, int tid, int lane, int wave) {
    asm volatile("" : "+v"(tid), "+v"(lane));
    LAS float* qs = L; LAS float* pw = L + 256 + wave * 256; LAS float* OC = L + 256 + 2048; LAS float* ML = OC + 256; LAS float* OS = ML + 128; LAS float* OW = OS + 2048;
    const int row = MP + sb, t = PAST;
    if (tid < 64) { const v2u qq = *(const v2u*)(A.Q + (size_t)row * 512 + kvh * 256 + tid * 4);
        f32x4 qf; qf.x = bf2f((unsigned short)(qq.x & 0xffffu)); qf.y = bf2f((unsigned short)(qq.x >> 16)); qf.z = bf2f((unsigned short)(qq.y & 0xffffu)); qf.w = bf2f((unsigned short)(qq.y >> 16));
        *(LAS f32x4*)(qs + tid * 4) = qf; }
    int pagev = 0; if (lane < 32) pagev = A.page_table[sb * NPAGES + (lane >> 1)];
    LAS float* NK = OW + 2048;
    if (wave == 7) { const int which = lane >> 4, d = 4 * (lane & 15); const float* p1 = (which < 2 ? A.ks_s + (size_t)sb * 256 : A.KWF + (size_t)row * 256) + kvh * 64 + (which & 1) * 128 + d;
        *(LAS f32x4*)(NK + which * 64 + d) = *(const f32x4*)p1; }
    __syncthreads();
    float slope[4];
    float l2e = LOG2E; asm volatile("" : "+v"(l2e));
#pragma unroll
    for (int h = 0; h < 4; ++h) slope[h] = exp2f(-(float)(kvh * 4 + h + 1)) * l2e;
    const int d4 = lane & 15, jq = lane >> 4;
    f32x4 qr[4];
#pragma unroll
    for (int h = 0; h < 4; ++h) qr[h] = *(const LAS f32x4*)(qs + h * 64 + 4 * d4);
    float pdum[8][4];
    unsigned long long mask;
    { float mc[4], lc[4], pk[8][4], inv[4]; f32x4 oc[4];
#pragma unroll
      for (int h = 0; h < 4; ++h) { mc[h] = -1e30f; lc[h] = 0.f; oc[h] = (f32x4){0.f, 0.f, 0.f, 0.f}; }
      seg3<1, true>(qr, A.KCS + ((size_t)l * DECB + sb) * 32 * 256 + kvh * 64, 32, 63, 64, t, 0, slope, lane, mc, lc, oc, pk);
#pragma unroll
      for (int h = 0; h < 4; ++h) { const float lt = jq_sum(lc[h]); inv[h] = lt > 0.f ? 1.f / lt : 0.f; oc[h] = red_jq(oc[h], lane) * inv[h]; }
#pragma unroll
      for (int i = 0; i < 8; ++i) { const float v = (pk[i][0] * inv[0] + pk[i][1] * inv[1]) + (pk[i][2] * inv[2] + pk[i][3] * inv[3]); if (d4 == 0) pw[4 * i + jq] = v; }
      LDS_WAIT(); asm volatile("" ::: "memory");
      const float imp = lane < 32 ? pw[lane] : 0.f;
      LDS_WAIT(); asm volatile("" ::: "memory");
      if (wave == 0 && lane < 16) {
#pragma unroll
          for (int h = 0; h < 4; ++h) *(LAS f32x4*)(OC + h * 64 + 4 * d4) = oc[h]; }
      const int nblk = 33, cur = t >> 6;
      float score;
      if (lane >= nblk) score = -3e4f; else if (lane == 0 || lane == cur) score = 1e4f; else if (lane <= cur) score = imp; else score = -1e4f;
      int rank = 0;
      for (int j = 0; j < nblk; ++j) { const float sj = rdlane(score, j); rank += (sj > score || (sj == score && j < lane)) ? 1 : 0; }
      mask = __ballot(rank < 16 && score > -5000.f);
    }
    float ms[4], ls[4]; f32x4 os[4];
#pragma unroll
    for (int h = 0; h < 4; ++h) { ms[h] = -1e30f; ls[h] = 0.f; os[h] = (f32x4){0.f, 0.f, 0.f, 0.f}; }
    { int k = 0;
      while (mask) { const int j = __builtin_ctzll(mask); mask &= mask - 1;
          if ((k >> 1) == wave) {
              const float* base; int count = 64;
              if (j < 32) { const int page = __builtin_amdgcn_readlane(pagev, j); base = A.cache_sel + (((size_t)l * NPHYS + page) * PAGE + (j & 1) * 64) * 256 + kvh * 64;
                  seg3<2, false>(qr, base, count, 64 * j, 1, t, 0, slope, lane, ms, ls, os, pdum); }
              else seg_one(qr, *(const LAS f32x4*)(NK + 4 * d4), *(const LAS f32x4*)(NK + 64 + 4 * d4), slope, (float)(t - 64 * j), lane, ms, ls, os); }
          ++k; } }
    float mw[4], lw[4]; f32x4 ow[4];
#pragma unroll
    for (int h = 0; h < 4; ++h) { mw[h] = -1e30f; lw[h] = 0.f; ow[h] = (f32x4){0.f, 0.f, 0.f, 0.f}; }
    { const int lo = PAST - (WINDOW - 1), p0 = lo + 64 * wave, count = (PAST - p0) < 64 ? (PAST - p0) : 64;
      seg3<2, false>(qr, A.cache_win + (((size_t)l * DECB + sb) * 512 + (p0 - (PAST - 512))) * 256 + kvh * 64, count, p0, 1, t, lo, slope, lane, mw, lw, ow, pdum);
      if (wave == 7) seg_one(qr, *(const LAS f32x4*)(NK + 128 + 4 * d4), *(const LAS f32x4*)(NK + 192 + 4 * d4), slope, (float)(t - PAST), lane, mw, lw, ow); }
#pragma unroll
    for (int h = 0; h < 4; ++h) { os[h] = red_jq(os[h], lane); ow[h] = red_jq(ow[h], lane); ls[h] = jq_sum(ls[h]); lw[h] = jq_sum(lw[h]); }
    if (lane < 16) {
#pragma unroll
        for (int h = 0; h < 4; ++h) { *(LAS f32x4*)(OS + wave * 256 + h * 64 + 4 * d4) = os[h]; *(LAS f32x4*)(OW + wave * 256 + h * 64 + 4 * d4) = ow[h]; } }
    if (lane == 0) {
#pragma unroll
        for (int h = 0; h < 4; ++h) { ML[wave * 16 + h] = ms[h]; ML[wave * 16 + 4 + h] = ls[h]; ML[wave * 16 + 8 + h] = mw[h]; ML[wave * 16 + 12 + h] = lw[h]; } }
    __syncthreads();
    if (tid < 256) { const int h = tid >> 6, dd = tid & 63;
        const float* g = A.GT + (size_t)row * 32 + (kvh * 4 + h) * 3; const size_t idx = (size_t)row * 512 + kvh * 256 + h * 64 + dd;
        const float g0 = g[0], g1 = g[1], g2 = g[2], zav = bf2f(A.ZA[idx]);
        float Ms = -1e30f, Mw = -1e30f;
#pragma unroll
        for (int w = 0; w < 8; ++w) { Ms = fmaxf(Ms, ML[w * 16 + h]); Mw = fmaxf(Mw, ML[w * 16 + 8 + h]); }
        float Ls = 0.f, Lw = 0.f, Os = 0.f, Ow = 0.f;
#pragma unroll
        for (int w = 0; w < 8; ++w) { const float fs = exp2f(ML[w * 16 + h] - Ms), fw = exp2f(ML[w * 16 + 8 + h] - Mw);
            Ls += ML[w * 16 + 4 + h] * fs; Lw += ML[w * 16 + 12 + h] * fw; Os += OS[w * 256 + h * 64 + dd] * fs; Ow += OW[w * 256 + h * 64 + dd] * fw; }
        const float ya = g0 * OC[h * 64 + dd] + g1 * Os / fmaxf(Ls, 1e-30f) + g2 * Ow / fmaxf(Lw, 1e-30f);
        qs[tid] = ya * zav; }
    __syncthreads();
    if (tid < 64) { const f32x4 y = *(const LAS f32x4*)(qs + 4 * tid);
        const unsigned long long w = (unsigned long long)pk2(y.x, y.y) | ((unsigned long long)pk2(y.z, y.w) << 32);
        __hip_atomic_store((unsigned long long*)(A.MIX + (size_t)row * 1024 + kvh * 256 + 4 * tid), w, __ATOMIC_RELAXED, __HIP_MEMORY_SCOPE_AGENT); }
    asm volatile("s_waitcnt vmcnt(0)" ::: "memory");
    __syncthreads();
    if (tid == 0) __hip_atomic_fetch_add(A.cnt, 1u, __ATOMIC_RELAXED, __HIP_MEMORY_SCOPE_AGENT);
}


#ifndef REP_CMP
#define REP_CMP 1
#endif
#ifndef REP_SEL
#define REP_SEL 1
#endif
#ifndef REP_WIN
#define REP_WIN 1
#endif
namespace att {
typedef short bf16x8 __attribute__((ext_vector_type(8)));
typedef short s16x4 __attribute__((ext_vector_type(4)));
typedef short v4i16_t __attribute__((ext_vector_type(4)));
typedef float f32x16 __attribute__((ext_vector_type(16)));
typedef __bf16 bf16x2_t __attribute__((ext_vector_type(2)));
typedef float f32x2_t __attribute__((ext_vector_type(2)));
typedef LAS const char* lds_cptr;
constexpr int KVB = 16384;
constexpr int OFF_WS = 2 * KVB, WS_STRIDE = 8704 + 2048;
constexpr int OFF_MASK = OFF_WS + 8 * WS_STRIDE;
constexpr int ATT_LDS = OFF_MASK + 512;
constexpr float NEG = -2e30f, MINIT = -1e30f;
#define ADI __device__ __forceinline__
ADI unsigned cvtpk(float lo, float hi) { f32x2_t v = {lo, hi}; bf16x2_t b = __builtin_convertvector(v, bf16x2_t); return __builtin_bit_cast(unsigned, b); }
ADI f32x16 mfma32(bf16x8 a, bf16x8 b, f32x16 c) { return __builtin_amdgcn_mfma_f32_32x32x16_bf16(a, b, c, 0, 0, 0); }
ADI s16x4 vtr(lds_cptr p) { return __builtin_bit_cast(s16x4, __builtin_amdgcn_ds_read_tr16_b64_v4i16((LAS v4i16_t*)p)); }
ADI float xhalf_max(float m) { auto rr = __builtin_amdgcn_permlane32_swap(__float_as_uint(m), __float_as_uint(m), false, false); return fmaxf(__uint_as_float(rr[0]), __uint_as_float(rr[1])); }
ADI float xhalf_sum(float m) { auto rr = __builtin_amdgcn_permlane32_swap(__float_as_uint(m), __float_as_uint(m), false, false); return __uint_as_float(rr[0]) + __uint_as_float(rr[1]); }
template <int CTRL> ADI float qperm(float v) { return __builtin_bit_cast(float, __builtin_amdgcn_update_dpp(0, __builtin_bit_cast(int, v), CTRL, 0xF, 0xF, true)); }
ADI bf16x8 pack8(const f32x16& x, int s) { v4u p; p.x = cvtpk(x[8 * s], x[8 * s + 1]); p.y = cvtpk(x[8 * s + 2], x[8 * s + 3]); p.z = cvtpk(x[8 * s + 4], x[8 * s + 5]); p.w = cvtpk(x[8 * s + 6], x[8 * s + 7]); return __builtin_bit_cast(bf16x8, p); }
constexpr int crow_c(int i) { return (i & 3) + 8 * (i >> 2); }

ADI void stage_store(LAS char* buf, int tid, v4u kr, v4u vr) {
    const int row = tid >> 3, ch = tid & 7;
    *(LAS v4u*)(buf + row * 128 + 16 * (ch ^ ((row >> 1) & 7))) = kr;
    *(LAS v4u*)(buf + 8192 + row * 128 + 16 * (ch ^ (4 * ((row >> 1) & 1)))) = vr;
}
ADI void k_load(bf16x8 (&kf)[2][4], lds_cptr kb, int r, int h) {
    const int sw = (r >> 1) & 7;
#pragma unroll
    for (int kbk = 0; kbk < 2; ++kbk)
#pragma unroll
        for (int s = 0; s < 4; ++s) kf[kbk][s] = *(const LAS bf16x8*)(kb + (32 * kbk + r) * 128 + 16 * ((2 * s + h) ^ sw));
}
ADI void qk_mma(f32x16 (&S)[2], const bf16x8 (&kf)[2][4], const bf16x8 (&qf)[4]) {
#pragma unroll
    for (int s = 0; s < 4; ++s)
#pragma unroll
        for (int kbk = 0; kbk < 2; ++kbk) S[kbk] = mfma32(kf[kbk][s], qf[s], S[kbk]);
}
ADI void v_load(bf16x8 (&vf)[2][2], lds_cptr vb, int kbk, int lane) {
    const int i16 = lane & 15, q = i16 >> 2, p = i16 & 3, blk = (lane >> 4) & 1, h = lane >> 5, sq = (q >> 1) & 1;
    lds_cptr base = vb + (4 * h + q) * 128 + 16 * (2 * blk + (p >> 1)) + 8 * (p & 1);
#pragma unroll
    for (int s = 0; s < 2; ++s)
#pragma unroll
        for (int db = 0; db < 2; ++db) {
            lds_cptr a = base + (32 * kbk + 16 * s) * 128 + 64 * (db ^ sq);
            const s16x4 lo = vtr(a), hi = vtr(a + 8 * 128);
            vf[s][db] = (bf16x8){lo[0], lo[1], lo[2], lo[3], hi[0], hi[1], hi[2], hi[3]};
        }
}
ADI void pv_mma(f32x16 (&O)[2], const bf16x8 (&vf)[2][2], const f32x16& P) {
#pragma unroll
    for (int s = 0; s < 2; ++s) {
        const bf16x8 pf = pack8(P, s);
#pragma unroll
        for (int db = 0; db < 2; ++db) O[db] = mfma32(vf[s][db], pf, O[db]);
    }
}
ADI void softmax_tile(f32x16 (&S)[2], f32x16 (&O)[2], float& m, float& l) {
    float mx = S[0][0];
#pragma unroll
    for (int i = 1; i < 16; ++i) mx = fmaxf(mx, S[0][i]);
#pragma unroll
    for (int i = 0; i < 16; ++i) mx = fmaxf(mx, S[1][i]);
    mx = xhalf_max(mx);
    const float mn = fmaxf(m, mx), alpha = __builtin_amdgcn_exp2f(m - mn);
    float sum = 0.f;
#pragma unroll
    for (int kbk = 0; kbk < 2; ++kbk)
#pragma unroll
        for (int i = 0; i < 16; ++i) { const float pv = __builtin_amdgcn_exp2f(S[kbk][i] - mn); S[kbk][i] = pv; sum += pv; }
    l = l * alpha + sum;
    if (__any(mn > m)) {
#pragma unroll
        for (int db = 0; db < 2; ++db)
#pragma unroll
            for (int i = 0; i < 16; ++i) O[db][i] *= alpha;
    }
    m = mn;
}
ADI void init_bias(f32x16 (&S)[2], float c0, float slope) {
#pragma unroll
    for (int kbk = 0; kbk < 2; ++kbk)
#pragma unroll
        for (int i = 0; i < 16; ++i) S[kbk][i] = fmaf(slope, (float)(32 * kbk + crow_c(i)), c0);
}
template <int MODE> ADI void mask_tile(f32x16 (&S)[2], int lim, int h) {
#pragma unroll
    for (int kbk = 0; kbk < 2; ++kbk)
#pragma unroll
        for (int i = 0; i < 16; ++i) { const int koff = 32 * kbk + crow_c(i) + 4 * h; const bool keep = (MODE == 1) ? (koff <= lim) : (koff > lim); S[kbk][i] = keep ? S[kbk][i] : NEG; }
}

struct Side { const float* src; float* dst; int c, cend, G, bx, pend; };
constexpr unsigned SIDE_N4 = 2u * 128u * 511u * 64u;
constexpr int OFF_SIDE = ATT_LDS, OFF_SIDE1 = 135168;
static_assert(OFF_SIDE + 8192 <= RING_BYTES && OFF_SIDE1 >= MISC_OFF + 1024 && OFF_SIDE1 + 8192 <= LDS_BYTES, "side-stream staging");
ADI unsigned side_idx(const Side& sd, int c, int tid) { return ((unsigned)c * (unsigned)sd.G + (unsigned)sd.bx) * 512u + (unsigned)tid; }
ADI void side_load(const Side& sd, int tid, int w, LAS char* lds) { const unsigned i = side_idx(sd, sd.c, tid); if (i < SIDE_N4) { const unsigned lb = i / 32704u, r = i - lb * 32704u;
    const float* p = sd.src + (size_t)lb * 131072 + 256 + (size_t)r * 4; const unsigned la = (unsigned)(size_t)(lds + ((sd.c & 1) ? OFF_SIDE1 : OFF_SIDE)) + (unsigned)w * 1024u;
    asm volatile("s_mov_b32 m0, %1\n\ts_nop 0\n\tglobal_load_lds_dwordx4 %0, off nt" :: "v"(p), "s"(la) : "memory", "m0"); } }
ADI void side_step(Side& sd, int tid, int w, LAS char* lds) {
    if (sd.pend) { const int c = sd.c - 1; const unsigned i = side_idx(sd, c, tid);
        asm volatile("s_waitcnt vmcnt(0)" ::: "memory");
        if (i < SIDE_N4) { const unsigned lb = i / 32704u, r = i - lb * 32704u; const f32x4 v = *(const LAS f32x4*)(lds + ((c & 1) ? OFF_SIDE1 : OFF_SIDE) + tid * 16); __builtin_nontemporal_store(v, (f32x4*)(sd.dst + (size_t)lb * 131072 + (size_t)r * 4)); }
        asm volatile("s_waitcnt lgkmcnt(0)" ::: "memory"); }
    const bool ld = sd.c < sd.cend; if (ld) side_load(sd, tid, w, lds);
    sd.pend = ld ? 1 : 0; if (ld) ++sd.c; }
struct Ptrs { const bf16* Q; const float* GT; const float* KCP; const bf16* KSB; const bf16* KWB; const bf16* ZA; bf16* MIX; };

ADI void unit(const Ptrs& A, int b, int kvh, int qb, LAS char* lds, int tid, int lane, int w, Side& sd) {
    asm volatile("" : "+v"(tid), "+v"(lane));
    const int r = lane & 31, h = lane >> 5, tl = r >> 2, g = r & 3, tokl = 8 * w + tl, t = 64 * qb + tokl, head = kvh * 4 + g;
    const size_t row = (size_t)b * SEQ + t;
    const float slope = __builtin_amdgcn_exp2f(-(float)(head + 1)) * LOG2E;
    bf16x8 qf[4];
#pragma unroll
    for (int s = 0; s < 4; ++s) qf[s] = *(const bf16x8*)(A.Q + row * 512 + head * 64 + 16 * s + 8 * h);
    const float g0 = A.GT[row * 32 + head * 3], g1 = A.GT[row * 32 + head * 3 + 1], g2 = A.GT[row * 32 + head * 3 + 2];
    LAS char* buf0 = lds; LAS char* buf1 = lds + KVB;
    { const int prow = tid >> 3, pc = tid & 7, chK = pc ^ ((prow >> 1) & 7), chV = pc ^ (4 * ((prow >> 1) & 1));
      const bf16* pk_ = A.KSB + ((size_t)b * SEQ + 64 * qb + prow) * 256 + kvh * 64; const bf16* sk_ = pk_ + chK * 8; const bf16* sv_ = pk_ + 128 + chV * 8;
      const unsigned la = (unsigned)(size_t)buf1 + (unsigned)w * 1024u;
      asm volatile("s_mov_b32 m0, %1\n\ts_nop 0\n\tglobal_load_lds_dwordx4 %0, off" :: "v"(sk_), "s"(la) : "memory", "m0");
      asm volatile("s_mov_b32 m0, %1\n\ts_nop 0\n\tglobal_load_lds_dwordx4 %0, off" :: "v"(sv_), "s"(la + 8192u) : "memory", "m0"); }
    LAS float* wsf = (LAS float*)(lds + OFF_WS + w * WS_STRIDE);
    LAS unsigned long long* masks = (LAS unsigned long long*)(lds + OFF_MASK);
    const int srow = tid >> 3, sch = tid & 7;
    LAS float* impf = wsf + 32 * 68;
    LAS float* yaf = wsf + r * 68 + 4 * h;
    for (int rep = 0; rep < REP_CMP; ++rep) {
        if (rep) __syncthreads();
        const float* kc = A.KCP + (((size_t)b * 64 + srow) * 4 + kvh) * 64 + sch * 8;
        const f32x4 k0 = *(const f32x4*)kc, k1 = *(const f32x4*)(kc + 4), v0 = *(const f32x4*)(kc + 128), v1 = *(const f32x4*)(kc + 132);
        v4u kr, vr; kr.x = cvtpk(k0.x, k0.y); kr.y = cvtpk(k0.z, k0.w); kr.z = cvtpk(k1.x, k1.y); kr.w = cvtpk(k1.z, k1.w);
        vr.x = cvtpk(v0.x, v0.y); vr.y = cvtpk(v0.z, v0.w); vr.z = cvtpk(v1.x, v1.y); vr.w = cvtpk(v1.z, v1.w);
        stage_store(buf0, tid, kr, vr);
        __syncthreads();
        f32x16 S[2], O[2];
        bf16x8 kf[2][4], vf0[2][2], vf1[2][2];
        k_load(kf, buf0, r, h);
        init_bias(S, slope * (float)(63 + 256 * h - t), slope * 64.f);
        qk_mma(S, kf, qf);
        v_load(vf0, buf0 + 8192, 0, lane);
        __builtin_amdgcn_sched_barrier(0);
        const int ncv = qb + (tokl == 63 ? 1 : 0);
        mask_tile<1>(S, ncv - 1, h);
#pragma unroll
        for (int db = 0; db < 2; ++db)
#pragma unroll
            for (int i = 0; i < 16; ++i) O[db][i] = 0.f;
        float m = MINIT, l = 0.f;
        softmax_tile(S, O, m, l);
        l = xhalf_sum(l);
        const float inv = l > 0.f ? 1.f / l : 0.f;
#pragma unroll
        for (int kbk = 0; kbk < 2; ++kbk)
#pragma unroll
            for (int i = 0; i < 16; ++i) S[kbk][i] *= inv;
#pragma unroll
        for (int kbk = 0; kbk < 2; ++kbk)
#pragma unroll
            for (int i = 0; i < 16; ++i) { float v = S[kbk][i]; v += qperm<0xB1>(v); v += qperm<0x4E>(v); if (g == 0) impf[tl * 64 + 32 * kbk + crow_c(i) + 4 * h] = v; }
        v_load(vf1, buf0 + 8192, 1, lane);
        pv_mma(O, vf0, S[0]);
        pv_mma(O, vf1, S[1]);
#pragma unroll
        for (int db = 0; db < 2; ++db)
#pragma unroll
            for (int gq = 0; gq < 4; ++gq) { const f32x4 v = {g0 * O[db][4 * gq], g0 * O[db][4 * gq + 1], g0 * O[db][4 * gq + 2], g0 * O[db][4 * gq + 3]}; *(LAS f32x4*)(yaf + 32 * db + 8 * gq) = v; }
    }
    LDS_WAIT(); asm volatile("" ::: "memory");
    if (qb < 16) { if (lane < 8) masks[8 * w + lane] = (2ull << qb) - 1ull; }
    else {
        const bool near = lane >= qb - 14 && lane < qb, far = lane >= 1 && lane < qb - 14;
        float vv[8], a_[8], b_[8];
#pragma unroll
        for (int k = 0; k < 8; ++k) { vv[k] = impf[k * 64 + lane]; a_[k] = near ? -vv[k] : -3e38f; b_[k] = far ? vv[k] : -3e38f; }
#pragma unroll
        for (int k = 0; k < 8; ++k) { a_[k] = wave_max(a_[k]); b_[k] = wave_max(b_[k]); }
#pragma unroll 1
        for (int k = 0; k < 8; ++k) {
            unsigned long long mk;
            float mn = 0.f, mf = 0.f;
#pragma unroll
            for (int q = 0; q < 8; ++q) if (q == k) { mn = -a_[q]; mf = b_[q]; }
            if (mn > mf) mk = (((1ull << 15) - 1ull) << (qb - 14)) | 1ull;
            else {
                float v = 0.f;
#pragma unroll
                for (int q = 0; q < 8; ++q) if (q == k) v = vv[q];
                const float score = (lane == 0 || lane == qb) ? 1e4f : (lane < qb ? v : -1e4f);
                int rank = 0;
                for (int j = 0; j <= qb; ++j) { const float sj = rdlane(score, j); rank += (sj > score || (sj == score && j < lane)) ? 1 : 0; }
                mk = __ballot(rank < 16 && lane <= qb); }
            if (lane == 0) masks[8 * w + k] = mk;
        }
    }
    __syncthreads();
    const unsigned long long mymask = masks[tokl];
    unsigned long long un = masks[lane];
#pragma unroll
    for (int o = 1; o < 64; o <<= 1) { const unsigned lo = shxu((unsigned)un, (lane ^ o) << 2), hi = shxu((unsigned)(un >> 32), (lane ^ o) << 2); un |= ((unsigned long long)hi << 32) | lo; }
    un = ((unsigned long long)(unsigned)__builtin_amdgcn_readfirstlane((unsigned)(un >> 32)) << 32) | (unsigned long long)(unsigned)__builtin_amdgcn_readfirstlane((unsigned)un);
    const unsigned long long un_all = un;
    int curw = 0;
    for (int rep = 0; rep < REP_SEL; ++rep) {
        if (rep) __syncthreads();
        un = un_all;
        f32x16 O[2];
#pragma unroll
        for (int db = 0; db < 2; ++db)
#pragma unroll
            for (int i = 0; i < 16; ++i) O[db][i] = 0.f;
        float m = MINIT, l = 0.f;
        const bf16* kbase = A.KSB + ((size_t)b * SEQ + srow) * 256 + kvh * 64 + sch * 8;
        int j = 63 - __builtin_clzll(un); un &= ~(1ull << j);
        if (rep) { const bf16* p = kbase + (size_t)j * 64 * 256; stage_store(buf1, tid, *(const v4u*)p, *(const v4u*)(p + 128)); }
        asm volatile("s_waitcnt vmcnt(0)" ::: "memory");
        __syncthreads();
        int cur = 1;
        for (;;) {
            const bool more = un != 0ull; int jn = 0; v4u kr, vr;
            side_step(sd, tid, w, lds);
            if (more) { jn = 63 - __builtin_clzll(un); un &= ~(1ull << jn); const bf16* p = kbase + (size_t)jn * 64 * 256; kr = *(const v4u*)p; vr = *(const v4u*)(p + 128); }
            else { const bf16* p = A.KWB + ((size_t)b * SEQ + srow + 64 * qb) * 256 + kvh * 64 + sch * 8; kr = *(const v4u*)p; vr = *(const v4u*)(p + 128); }
            LAS char* bc = cur ? buf1 : buf0;
            f32x16 S[2];
            const bool sel = (mymask >> j) & 1ull;
            bf16x8 kf[2][4], vf0[2][2], vf1[2][2];
            k_load(kf, bc, r, h);
            init_bias(S, sel ? slope * (float)(64 * j + 4 * h - t) : NEG, slope);
            qk_mma(S, kf, qf);
            v_load(vf0, bc + 8192, 0, lane);
            if (j == qb) mask_tile<1>(S, tokl, h);
            softmax_tile(S, O, m, l);
            v_load(vf1, bc + 8192, 1, lane);
        pv_mma(O, vf0, S[0]);
        pv_mma(O, vf1, S[1]);
            stage_store(cur ? buf0 : buf1, tid, kr, vr);
            __syncthreads();
            cur ^= 1; j = jn;
            if (!more) break;
        }
        curw = cur;
        l = xhalf_sum(l);
        const float sc = g1 / fmaxf(l, 1e-30f);
        if (rep == REP_SEL - 1)
#pragma unroll
        for (int db = 0; db < 2; ++db)
#pragma unroll
            for (int gq = 0; gq < 4; ++gq) { f32x4 v = *(const LAS f32x4*)(yaf + 32 * db + 8 * gq);
                v.x += sc * O[db][4 * gq]; v.y += sc * O[db][4 * gq + 1]; v.z += sc * O[db][4 * gq + 2]; v.w += sc * O[db][4 * gq + 3]; *(LAS f32x4*)(yaf + 32 * db + 8 * gq) = v; }
    }
    __syncthreads();
    for (int rep = 0; rep < REP_WIN; ++rep) {
        if (rep) __syncthreads();
        f32x16 O[2];
#pragma unroll
        for (int db = 0; db < 2; ++db)
#pragma unroll
            for (int i = 0; i < 16; ++i) O[db][i] = 0.f;
        float m = MINIT, l = 0.f;
        const bf16* kbase = A.KWB + ((size_t)b * SEQ + srow) * 256 + kvh * 64 + sch * 8;
        const int jlo = qb - 8 > 0 ? qb - 8 : 0; int j = qb;
        if (rep) { const bf16* p = kbase + (size_t)j * 64 * 256; stage_store(curw ? buf1 : buf0, tid, *(const v4u*)p, *(const v4u*)(p + 128)); __syncthreads(); }
        int cur = curw;
        for (;;) {
            const bool more = j > jlo; v4u kr, vr;
            side_step(sd, tid, w, lds);
            if (more) { const bf16* p = kbase + (size_t)(j - 1) * 64 * 256; kr = *(const v4u*)p; vr = *(const v4u*)(p + 128); }
            LAS char* bc = cur ? buf1 : buf0;
            f32x16 S[2];
            bf16x8 kf[2][4], vf0[2][2], vf1[2][2];
            k_load(kf, bc, r, h);
            init_bias(S, slope * (float)(64 * j + 4 * h - t), slope);
            qk_mma(S, kf, qf);
            v_load(vf0, bc + 8192, 0, lane);
            if (j == qb) mask_tile<1>(S, tokl, h);
            if (j == qb - 8) mask_tile<2>(S, tokl, h);
            softmax_tile(S, O, m, l);
            v_load(vf1, bc + 8192, 1, lane);
        pv_mma(O, vf0, S[0]);
        pv_mma(O, vf1, S[1]);
            if (!more) break;
            stage_store(cur ? buf0 : buf1, tid, kr, vr);
            __syncthreads();
            cur ^= 1; --j;
        }
        l = xhalf_sum(l);
        const float sc = g2 / fmaxf(l, 1e-30f);
        if (rep == REP_WIN - 1)
#pragma unroll
        for (int db = 0; db < 2; ++db)
#pragma unroll
            for (int gq = 0; gq < 4; ++gq) { f32x4 v = *(const LAS f32x4*)(yaf + 32 * db + 8 * gq);
                v.x += sc * O[db][4 * gq]; v.y += sc * O[db][4 * gq + 1]; v.z += sc * O[db][4 * gq + 2]; v.w += sc * O[db][4 * gq + 3]; *(LAS f32x4*)(yaf + 32 * db + 8 * gq) = v; }
    }
    v2u zg[8];
#pragma unroll
    for (int k = 0; k < 8; ++k) zg[k] = *(const v2u*)(A.ZA + ((size_t)b * SEQ + 64 * qb + 8 * w + k) * 512 + kvh * 256 + 4 * lane);
    LDS_WAIT(); asm volatile("" ::: "memory");
#pragma unroll
    for (int k = 0; k < 8; ++k) {
        const f32x4 y = *(const LAS f32x4*)(wsf + (4 * k + (lane >> 4)) * 68 + 4 * (lane & 15));
        const size_t orow = (size_t)b * SEQ + 64 * qb + 8 * w + k;
        const v2u z = zg[k];
        v2u o; o.x = cvtpk(y.x * bf2f((unsigned short)(z.x & 0xffffu)), y.y * bf2f((unsigned short)(z.x >> 16))); o.y = cvtpk(y.z * bf2f((unsigned short)(z.y & 0xffffu)), y.w * bf2f((unsigned short)(z.y >> 16)));
        *(v2u*)(A.MIX + orow * 1024 + kvh * 256 + 4 * lane) = o;
    }
    __syncthreads();
}
#undef ADI
}

namespace cmpk {
typedef short bf16x8 __attribute__((ext_vector_type(8)));
typedef float f32x16 __attribute__((ext_vector_type(16)));
typedef __bf16 bf16x2_t __attribute__((ext_vector_type(2)));
typedef float f32x2_t __attribute__((ext_vector_type(2)));
constexpr int OFF_W1T = 0, OFF_W2 = 16384, OFF_PART = OFF_W2 + 32768, OFF_X = OFF_PART + 2048, XBYTES = 32768, CMP_LDS = OFF_X + 2 * XBYTES;
#define CDI __device__ __forceinline__
CDI unsigned cvtpk(float lo, float hi) { f32x2_t v = {lo, hi}; bf16x2_t b = __builtin_convertvector(v, bf16x2_t); return __builtin_bit_cast(unsigned, b); }
CDI float xhalf_sum(float m) { auto rr = __builtin_amdgcn_permlane32_swap(__float_as_uint(m), __float_as_uint(m), false, false); return __uint_as_float(rr[0]) + __uint_as_float(rr[1]); }
CDI void stage_weights(const float* w1, const float* pe, LAS char* lds, int tid) {
    for (int q = tid; q < 1024; q += 512) { const int c = q & 7, e = (q >> 3) & 63, r = q >> 9; const float* s = w1 + ((size_t)r * 64 + 8 * c) * 64 + e;
        v4u o; o.x = cvtpk(s[0], s[64]); o.y = cvtpk(s[128], s[192]); o.z = cvtpk(s[256], s[320]); o.w = cvtpk(s[384], s[448]);
        *(LAS v4u*)(lds + OFF_W1T + (r * 64 + e) * 128 + 16 * (c ^ ((e >> 1) & 7))) = o; }
    for (int q = tid; q < 2048; q += 512) *(LAS f32x4*)(lds + OFF_W2 + q * 16) = *(const f32x4*)(pe + q * 4);
}
CDI void load_rows(const float* src, int tid, f32x4 (&v)[8]) {
#pragma unroll
    for (int k = 0; k < 8; ++k) v[k] = __builtin_nontemporal_load((const f32x4*)(src + (size_t)(tid + 512 * k) * 4));
}
CDI void store_rows(LAS char* xb, const LAS char* pe, int tid, const f32x4 (&v)[8]) {
    f32x4 p[8];
#pragma unroll
    for (int k = 0; k < 8; ++k) { const int q = tid + 512 * k, c = q >> 6, col = (q & 63) * 4, r = col >> 7, dd = col & 63; p[k] = *(const LAS f32x4*)(pe + ((r * 64 + c) * 64 + dd) * 4); }
    __builtin_amdgcn_sched_barrier(0);
#pragma unroll
    for (int k = 0; k < 8; ++k) { const int q = tid + 512 * k, c = q >> 6, col4 = q & 63;
        const f32x4 x = v[k] + p[k];
        v2u o; o.x = cvtpk(x.x, x.y); o.y = cvtpk(x.z, x.w);
        *(LAS v2u*)(xb + c * 512 + 16 * ((col4 >> 1) ^ (c & 15)) + 8 * (col4 & 1)) = o; }
}
template <class Job, bool WT = false> CDI void run(const Job& J, int n, const float* pe, const float* w1, const float* w2, LAS char* lds, int tid, int lane, int wave) {
    if (n <= 0) return;
    f32x4 va[8], vb[8];
    load_rows(J.src(0), tid, va);
    if (!WT || n > 1) load_rows(n > 1 ? J.src(1) : J.dummy(), tid, vb);
    const int rkF = wave >> 1, e2F = 32 * (wave & 1) + (lane & 31), ehF = lane >> 5;
    float w2r[32];
#pragma unroll
    for (int i = 0; i < 32; ++i) w2r[i] = w2[(size_t)(rkF >> 1) * 4096 + (32 * ehF + i) * 64 + e2F];
    stage_weights(w1, pe, lds, tid);
    __syncthreads();
    store_rows(lds + OFF_X, lds + OFF_W2, tid, va);
    __syncthreads();
    const int rk = wave & 3, th = wave >> 2, r = rk >> 1, r32 = lane & 31, h = lane >> 5;
    LAS float* part = (LAS float*)(lds + OFF_PART);
    bf16x8 bfr[2][4];
#pragma unroll
    for (int s = 0; s < 4; ++s)
#pragma unroll
        for (int eb = 0; eb < 2; ++eb) { const int e = 32 * eb + r32; bfr[eb][s] = *(const LAS bf16x8*)(lds + OFF_W1T + (r * 64 + e) * 128 + 16 * ((2 * s + h) ^ ((e >> 1) & 7))); }
    auto body = [&](int i) {
        const LAS char* X = lds + OFF_X + (i & 1) * XBYTES;
        f32x16 acc[2];
#pragma unroll
        for (int eb = 0; eb < 2; ++eb)
#pragma unroll
            for (int k = 0; k < 16; ++k) acc[eb][k] = 0.f;
        const int tok = 32 * th + r32;
        bf16x8 af[4];
#pragma unroll
        for (int s = 0; s < 4; ++s) af[s] = *(const LAS bf16x8*)(X + tok * 512 + 16 * ((8 * rk + 2 * s + h) ^ (tok & 15)));
        __builtin_amdgcn_sched_barrier(0);
#pragma unroll
        for (int s = 0; s < 4; ++s)
#pragma unroll
            for (int eb = 0; eb < 2; ++eb) acc[eb] = __builtin_amdgcn_mfma_f32_32x32x16_bf16(af[s], bfr[eb][s], acc[eb], 0, 0, 0);
#pragma unroll
        for (int eb = 0; eb < 2; ++eb) {
            f32x2_t s2 = {0.f, 0.f};
#pragma unroll
            for (int k = 0; k < 16; k += 2) { const f32x2_t x = {acc[eb][k], acc[eb][k + 1]}; f32x2_t t = x * -1.4426950408889634f;
                t.x = __builtin_amdgcn_exp2f(t.x); t.y = __builtin_amdgcn_exp2f(t.y); t = t + 1.f; t.x = __builtin_amdgcn_rcpf(t.x); t.y = __builtin_amdgcn_rcpf(t.y); s2 = s2 + x * t; }
            float sum = s2.x + s2.y;
            sum = xhalf_sum(sum);
            if (h == 0) part[wave * 64 + 32 * eb + r32] = sum; }
        __syncthreads();
        { float o = 0.f;
          const LAS f32x4* pa = (const LAS f32x4*)(part + rkF * 64 + 32 * ehF); const LAS f32x4* pb = (const LAS f32x4*)(part + (rkF + 4) * 64 + 32 * ehF);
          f32x4 qa[8], qb[8];
#pragma unroll
          for (int q = 0; q < 8; ++q) { qa[q] = pa[q]; qb[q] = pb[q]; }
          __builtin_amdgcn_sched_barrier(0);
#pragma unroll
          for (int q = 0; q < 8; ++q) { const f32x4 a = qa[q] + qb[q]; o += (a.x * w2r[4 * q] + a.y * w2r[4 * q + 1]) + (a.z * w2r[4 * q + 2] + a.w * w2r[4 * q + 3]); }
          o = xhalf_sum(o) * (1.f / 64.f);
          if (ehF == 0) {
              if (WT) __hip_atomic_store(J.dst(i) + rkF * 64 + e2F, o, __ATOMIC_RELAXED, __HIP_MEMORY_SCOPE_AGENT);
              else J.dst(i)[rkF * 64 + e2F] = o; } }
    };
#pragma nounroll
    for (int i = 0; i < n; i += 2) {
        if (!WT || i + 2 < n) load_rows(i + 2 < n ? J.src(i + 2) : J.dummy(), tid, va);
        body(i);
        if (i + 1 >= n) break;
        store_rows(lds + OFF_X + XBYTES, lds + OFF_W2, tid, vb);
        __syncthreads();
        if (!WT || i + 3 < n) load_rows(i + 3 < n ? J.src(i + 3) : J.dummy(), tid, vb);
        body(i + 1);
        if (i + 2 >= n) break;
        store_rows(lds + OFF_X, lds + OFF_W2, tid, va);
        __syncthreads();
    }
    asm volatile("s_waitcnt vmcnt(0)" ::: "memory");
    __syncthreads();
}
#undef CDI
}

namespace gm {
typedef short bf16x8 __attribute__((ext_vector_type(8)));
typedef short s16x4 __attribute__((ext_vector_type(4)));
typedef short v4i16_t __attribute__((ext_vector_type(4)));
typedef float f32x16 __attribute__((ext_vector_type(16)));
#define GDI __device__ __forceinline__
GDI s16x4 vtr(const LAS char* p) { return __builtin_bit_cast(s16x4, __builtin_amdgcn_ds_read_tr16_b64_v4i16((LAS v4i16_t*)p)); }
constexpr int crow_c(int i) { return (i & 3) + 8 * (i >> 2); }
GDI void unit(const float* V, const float* U, const bf16* ZC, bf16* MIX, const float* gn, const bf16* WGB, const float* gbs, float* gv_out, int row0, int gp, LAS char* lds, int tid, int lane, int wave) {
    const float gn0 = gn[(2 * gp) * 64 + lane], gn1 = gn[(2 * gp + 1) * 64 + lane];
    for (int it0 = 0; it0 < 32; it0 += 16) {
        float v[16];
#pragma unroll
        for (int k = 0; k < 16; ++k) { const int it = wave * 32 + it0 + k, i = it >> 1, g = 2 * gp + (it & 1); v[k] = V[(size_t)(row0 + i) * 256 + g * 64 + lane]; }
#pragma unroll
        for (int k = 0; k < 16; ++k) { const int it = wave * 32 + it0 + k, i = it >> 1, g = 2 * gp + (it & 1), ch = g * 64 + lane;
            const float ss = wave_sum(v[k] * v[k]);
            const float vn = v[k] * (1.f / sqrtf(ss * (1.f / 64.f) + EPS)) * ((it & 1) ? gn1 : gn0);
            if (gv_out) gv_out[(size_t)i * 256 + ch] = vn;
            *(LAS unsigned short*)(lds + i * 512 + 64 * ((ch >> 5) ^ (i & 3)) + 2 * (ch & 31)) = (unsigned short)f2bf(vn); }
    }
    __syncthreads();
    const int g = 2 * gp + (wave & 1), ib = wave >> 1, r32 = lane & 31, h = lane >> 5, q = (lane & 15) >> 2, p = lane & 3, blk = (lane >> 4) & 1;
    f32x16 acc[2];
#pragma unroll
    for (int b = 0; b < 2; ++b)
#pragma unroll
        for (int k = 0; k < 16; ++k) acc[b][k] = 0.f;
    { const bf16* wrow = WGB + ((size_t)(g * 128 + 32 * ib + r32)) * 128 + 8 * h;
      const int ns = 2 * (ib + 1);
      bf16x8 af[8];
#pragma unroll
      for (int s = 0; s < 8; ++s) af[s] = *(const bf16x8*)(wrow + 16 * (s < ns ? s : 0));
#pragma unroll
      for (int s = 0; s < 8; ++s) { if (s < ns) {
          const bf16x8 a = af[s];
#pragma unroll
          for (int cb = 0; cb < 2; ++cb) {
              const int col = g * 64 + 32 * cb + 16 * blk + 4 * p, row = 16 * s + 8 * h + q;
              const LAS char* ad = lds + row * 512 + 64 * ((col >> 5) ^ q) + 2 * (col & 31);
              const s16x4 lo = vtr(ad), hi = vtr(ad + 4 * 512);
              const bf16x8 bfr = {lo[0], lo[1], lo[2], lo[3], hi[0], hi[1], hi[2], hi[3]};
              acc[cb] = __builtin_amdgcn_mfma_f32_32x32x16_bf16(a, bfr, acc[cb], 0, 0, 0);
          }
      } } }
#pragma unroll
    for (int cb = 0; cb < 2; ++cb) {
        float uu[16], gb[16]; unsigned short zz[16];
#pragma unroll
        for (int k = 0; k < 16; ++k) { const int i = 32 * ib + crow_c(k) + 4 * h, ch = g * 64 + 32 * cb + r32; const size_t row = (size_t)row0 + i; uu[k] = U[row * 256 + ch]; zz[k] = ZC[row * 256 + ch]; gb[k] = gbs[g * 128 + i]; }
#pragma unroll
        for (int k = 0; k < 16; ++k) { const int i = 32 * ib + crow_c(k) + 4 * h, ch = g * 64 + 32 * cb + r32; const size_t row = (size_t)row0 + i;
            const float s = acc[cb][k] + gb[k];
            MIX[row * 1024 + 768 + ch] = (bf16)f2bf(uu[k] * s * bf2f(zz[k])); }
    }
    __syncthreads();
}
#undef GDI
}

namespace sk {
typedef short bf16x8 __attribute__((ext_vector_type(8)));
template <class P, class F> __device__ __forceinline__ void slab2(const bf16* A, const bf16* Bt, LAS float* part, int lane, int wave, const P& pre, const F& emit) {
    asm volatile("" : "+v"(lane));
    const int r16 = lane & 15, kq = lane >> 4;
    const bf16* ap = A + (size_t)r16 * 1024 + 128 * wave + 8 * kq;
    const bf16* bp = Bt + (size_t)r16 * 1024 + 128 * wave + 8 * kq;
    float pv[4];
#pragma unroll
    for (int reg = 0; reg < 4; ++reg) pv[reg] = pre(16 * wave + 4 * kq + reg);
    bf16x8 b[2][4];
#pragma unroll
    for (int c = 0; c < 2; ++c)
#pragma unroll
        for (int s = 0; s < 4; ++s) b[c][s] = *(const bf16x8*)(bp + (size_t)c * 16 * 1024 + 32 * s);
    bf16x8 a[2][4][4];
#pragma unroll
    for (int rh = 0; rh < 2; ++rh)
#pragma unroll
        for (int rb = 0; rb < 4; ++rb)
#pragma unroll
            for (int s = 0; s < 4; ++s) a[rh][rb][s] = *(const bf16x8*)(ap + (size_t)(4 * rh + rb) * 16 * 1024 + 32 * s);
#pragma unroll
    for (int rh = 0; rh < 2; ++rh) {
#pragma unroll
        for (int rb = 0; rb < 4; ++rb)
#pragma unroll
            for (int c = 0; c < 2; ++c) { f32x4 acc = {0.f, 0.f, 0.f, 0.f};
#pragma unroll
                for (int s = 0; s < 4; ++s) acc = __builtin_amdgcn_mfma_f32_16x16x32_bf16(a[rh][rb][s], b[c][s], acc, 0, 0, 0);
#pragma unroll
                for (int reg = 0; reg < 4; ++reg) part[(wave * 128 + 16 * (4 * rh + rb) + 4 * kq + reg) * 32 + 16 * c + r16] = acc[reg]; }
    }
    __syncthreads();
#pragma unroll
    for (int c = 0; c < 2; ++c)
#pragma unroll
        for (int reg = 0; reg < 4; ++reg) { const int row = 16 * wave + 4 * kq + reg; float sum = 0.f;
#pragma unroll
            for (int pw = 0; pw < 8; ++pw) sum += part[(pw * 128 + row) * 32 + 16 * c + r16];
            emit(row, 16 * c + r16, sum, pv[reg]); }
    __syncthreads();
}
__device__ __forceinline__ void sample_out(const bf16* A, const bf16* Bt, unsigned char* ws, float* out, const float* x_sample, const float* gpost, unsigned* ctl, int l, int u, LAS float* part, int tid, int lane, int wave) {
    asm volatile("" : "+v"(lane));
    const int r16 = lane & 15, kq = lane >> 4;
    const bf16* ap = A + (size_t)r16 * 1024 + 128 * wave + 8 * kq;
    const bf16* bp = Bt + (size_t)r16 * 1024 + 128 * wave + 8 * kq;
    bf16x8 b[2][4];
#pragma unroll
    for (int c = 0; c < 2; ++c)
#pragma unroll
        for (int s2 = 0; s2 < 4; ++s2) b[c][s2] = *(const bf16x8*)(bp + (size_t)c * 16 * 1024 + 32 * s2);
#pragma unroll
    for (int rh = 0; rh < 2; ++rh) { bf16x8 a[4][4];
#pragma unroll
        for (int rb = 0; rb < 4; ++rb)
#pragma unroll
            for (int s2 = 0; s2 < 4; ++s2) a[rb][s2] = *(const bf16x8*)(ap + (size_t)(4 * rh + rb) * 16 * 1024 + 32 * s2);
#pragma unroll
        for (int rb = 0; rb < 4; ++rb)
#pragma unroll
            for (int c = 0; c < 2; ++c) { f32x4 acc = {0.f, 0.f, 0.f, 0.f};
#pragma unroll
                for (int s2 = 0; s2 < 4; ++s2) acc = __builtin_amdgcn_mfma_f32_16x16x32_bf16(a[rb][s2], b[c][s2], acc, 0, 0, 0);
#pragma unroll
                for (int reg = 0; reg < 4; ++reg) part[(wave * 128 + 16 * (4 * rh + rb) + 4 * kq + reg) * 32 + 16 * c + r16] = acc[reg]; }
    }
    __syncthreads();
    float v[2][4];
#pragma unroll
    for (int c = 0; c < 2; ++c)
#pragma unroll
        for (int reg = 0; reg < 4; ++reg) { const int row = 16 * wave + 4 * kq + reg; float sum = 0.f;
#pragma unroll
            for (int pw = 0; pw < 8; ++pw) sum += part[(pw * 128 + row) * 32 + 16 * c + r16];
            v[c][reg] = sum; }
    __syncthreads();
    float* slots = (float*)(ws + pg8::G1_XS) + (size_t)2 * pg8::E_MP * 4 + (size_t)l * 128 * 32;
    unsigned* cnt = ctl + pg8::CW_SEAM + (l * 65 + 64) * 64;
    LAS float* S = part; LAS unsigned* flag = (LAS unsigned*)(part + 128);
#pragma unroll
    for (int reg = 0; reg < 4; ++reg) { float q = v[0][reg] * v[0][reg] + v[1][reg] * v[1][reg];
        q += dppf<0xB1>(q); q += dppf<0x4E>(q); q += dppf<0x141>(q); q += dppf<0x140>(q);
        if (r16 == 0) __hip_atomic_store(slots + (size_t)(16 * wave + 4 * kq + reg) * 32 + u, q, __ATOMIC_RELAXED, __HIP_MEMORY_SCOPE_AGENT); }
    asm volatile("s_waitcnt vmcnt(0)" ::: "memory"); __syncthreads();
    if (tid == 0) __hip_atomic_fetch_add(cnt, 1u, __ATOMIC_RELAXED, __HIP_MEMORY_SCOPE_AGENT);
    if (wave == 0) { bool dead = false; unsigned sp = 0;
        while ((unsigned)__builtin_amdgcn_readfirstlane(__hip_atomic_load(cnt, __ATOMIC_RELAXED, __HIP_MEMORY_SCOPE_AGENT)) < 32u) { __builtin_amdgcn_s_sleep(2); if (++sp > (1u << 16)) { dead = true; break; } }
        __builtin_amdgcn_fence(__ATOMIC_ACQUIRE, "agent");
        if (lane == 0) flag[0] = dead ? 1u : 0u; }
    asm volatile("s_waitcnt vmcnt(0) lgkmcnt(0)" ::: "memory"); __syncthreads();
    if (tid < 128) { float ss = 0.f;
        for (int j = 0; j < 32; ++j) ss += __hip_atomic_load(slots + (size_t)tid * 32 + j, __ATOMIC_RELAXED, __HIP_MEMORY_SCOPE_AGENT);
        S[tid] = flag[0] ? __builtin_nanf("") : 1.f / sqrtf(ss * (1.f / 1024.f) + 1e-6f); }
    __syncthreads();
    bf16* XB = (bf16*)(ws + WS_XB); float* RSN = (float*)(ws + WS_RS) + MPAD;
    unsigned short xr[4][2]; float gp2[2];
#pragma unroll
    for (int c = 0; c < 2; ++c) { gp2[c] = gpost[32 * u + 16 * c + r16];
#pragma unroll
        for (int reg = 0; reg < 4; ++reg) xr[reg][c] = XB[(size_t)(MP + 16 * wave + 4 * kq + reg) * 1024 + 32 * u + 16 * c + r16]; }
#pragma unroll
    for (int reg = 0; reg < 4; ++reg) { const int row = 16 * wave + 4 * kq + reg; const float r = S[row]; float q = 0.f;
#pragma unroll
        for (int c = 0; c < 2; ++c) { const int col = 32 * u + 16 * c + r16; const size_t idx = (size_t)(MP + row) * 1024 + col;
            const float x = bf2f(xr[reg][c]);
            const float y = x + v[c][reg] * r * gp2[c];
            if (l == 0) { XB[idx] = (bf16)f2bf(y); q += y * y; } else out[O_Y_S + (size_t)row * 1024 + col] = y; }
        if (l == 0) { q += dppf<0xB1>(q); q += dppf<0x4E>(q); q += dppf<0x141>(q); q += dppf<0x140>(q);
            if (r16 == 0) __hip_atomic_fetch_add(RSN + MP + row, q, __ATOMIC_RELAXED, __HIP_MEMORY_SCOPE_AGENT); } }
    __syncthreads();
}
__device__ __forceinline__ void emit_g1_sample(unsigned char* ws, float* out, int l, int sb, int c, float v) {
    const size_t row = (size_t)MP + sb;
    if (c < 512) ((bf16*)(ws + WS_Q))[row * 512 + c] = (bf16)f2bf(v * pg8::QSCALE);
    else if (c < 768) out[O_KC_S + ((size_t)l * DECB + sb) * 256 + (c - 512)] = v;
    else if (c < 1024) out[O_KS_S + ((size_t)l * DECB + sb) * 256 + (c - 768)] = v;
    else if (c < 1280) { ((float*)(ws + WS_KWF))[row * 256 + (c - 1024)] = v; out[O_KW_S + (((size_t)l * DECB + sb) * 512 + 511) * 256 + (c - 1024)] = v; }
    else if (c < 1792) ((bf16*)(ws + WS_ZA))[row * 512 + (c - 1280)] = (bf16)f2bf(siluf_(v));
    else if (c < 2048) { ((float*)(ws + WS_PIN))[row * 256 + (c - 1792)] = v; out[O_PL_S + (((size_t)l * DECB + sb) * 15 + 14) * 256 + (c - 1792)] = v; }
    else if (c < 2304) ((bf16*)(ws + WS_ZB))[row * 256 + (c - 2048)] = (bf16)f2bf(siluf_(v));
    else if (c < 2560) ((float*)(ws + WS_U))[row * 256 + (c - 2304)] = v;
    else if (c < 2816) ((float*)(ws + WS_V))[row * 256 + (c - 2560)] = v;
    else if (c < 3072) ((bf16*)(ws + WS_ZC))[row * 256 + (c - 2816)] = (bf16)f2bf(siluf_(v));
}
}

namespace pl {
typedef short bf16x8 __attribute__((ext_vector_type(8)));
typedef float f32x16 __attribute__((ext_vector_type(16)));
constexpr int OFF_WPT = 0, OFF_DF = 32768, POOL_LDS = 65536;
constexpr int crow_c(int i) { return (i & 3) + 8 * (i >> 2); }
#define PDI __device__ __forceinline__
PDI void stage_weights(const float* pw, LAS char* lds, int tid) {
    for (int q = tid; q < 2048; q += 512) { const int c8 = q & 7, e = (q >> 3) & 63, g = q >> 9; const float* s = pw + ((size_t)g * 64 + 8 * c8) * 64 + e;
        v4u o; o.x = pk2(s[0], s[64]); o.y = pk2(s[128], s[192]); o.z = pk2(s[256], s[320]); o.w = pk2(s[384], s[448]);
        *(LAS v4u*)(lds + OFF_WPT + (g * 64 + e) * 128 + 16 * (c8 ^ ((e >> 1) & 7))) = o; }
}
PDI void put_diff(LAS char* lds, int tok, int ch, float d) { *(LAS unsigned short*)(lds + OFF_DF + tok * 512 + 16 * ((ch >> 3) ^ (tok & 15)) + 2 * (ch & 7)) = (unsigned short)f2bf(d); }
template <int W> PDI void diff_prompt(const float* pin_b, int t0, int ch, int half, LAS char* lds) {
    const int ts = t0 + 32 * half;
    float cur[32], old[32];
#pragma unroll
    for (int i = 0; i < 32; ++i) { cur[i] = pin_b[(size_t)(ts + i) * 256 + ch]; const int to = ts + i - W; old[i] = to >= 0 ? pin_b[(size_t)to * 256 + ch] : 0.f; }
    float s = 0.f;
#pragma unroll
    for (int k = 1; k <= W; ++k) { const int tp = ts - k; s += tp >= 0 ? pin_b[(size_t)tp * 256 + ch] : 0.f; }
#pragma unroll
    for (int i = 0; i < 32; ++i) { s += cur[i] - old[i]; const int t = ts + i; const int cnt = (t + 1) < W ? (t + 1) : W;
        put_diff(lds, 32 * half + i, ch, s * __builtin_amdgcn_rcpf((float)cnt) - cur[i]); }
}
template <int W> PDI void diff_sample(const float* PIN, const float* state_l, int sb0, int ch, int half, LAS char* lds) {
#pragma unroll 1
    for (int i0 = 0; i0 < 16; i0 += 2) { float v[2][W];
#pragma unroll
        for (int j = 0; j < 2; ++j) { const int sb = sb0 + 16 * half + i0 + j; v[j][0] = PIN[(size_t)(MP + sb) * 256 + ch];
#pragma unroll
            for (int k = 1; k < W; ++k) v[j][k] = state_l[((size_t)sb * 15 + (15 - k)) * 256 + ch]; }
#pragma unroll
        for (int j = 0; j < 2; ++j) { float s = v[j][0];
#pragma unroll
            for (int k = 1; k < W; ++k) s += v[j][k];
            put_diff(lds, 16 * half + i0 + j, ch, s * (1.0f / (float)W) - v[j][0]); } }
}
PDI void mma_store(const float* psc, const bf16* ZB, bf16* MIX, size_t row0, int nth, LAS char* lds, int lane, int wave) {
    const int g = wave & 3, th = wave >> 2, r32 = lane & 31, h = lane >> 5;
    if (th >= nth) return;
    f32x16 acc[2];
#pragma unroll
    for (int eb = 0; eb < 2; ++eb)
#pragma unroll
        for (int k = 0; k < 16; ++k) acc[eb][k] = 0.f;
    const int tok = 32 * th + r32;
#pragma unroll
    for (int s = 0; s < 4; ++s) {
        const bf16x8 a = *(const LAS bf16x8*)(lds + OFF_DF + tok * 512 + 16 * ((8 * g + 2 * s + h) ^ (tok & 15)));
#pragma unroll
        for (int eb = 0; eb < 2; ++eb) { const int e = 32 * eb + r32;
            const bf16x8 b = *(const LAS bf16x8*)(lds + OFF_WPT + (g * 64 + e) * 128 + 16 * ((2 * s + h) ^ ((e >> 1) & 7)));
            acc[eb] = __builtin_amdgcn_mfma_f32_32x32x16_bf16(a, b, acc[eb], 0, 0, 0); }
    }
#pragma unroll
    for (int eb = 0; eb < 2; ++eb) { const int ch = g * 64 + 32 * eb + r32; const float sc = psc[ch];
        unsigned short zz[16];
#pragma unroll
        for (int k = 0; k < 16; ++k) zz[k] = ZB[(row0 + 32 * th + crow_c(k) + 4 * h) * 256 + ch];
#pragma unroll
        for (int k = 0; k < 16; ++k) { const size_t row = row0 + 32 * th + crow_c(k) + 4 * h; MIX[row * 1024 + 512 + ch] = (bf16)f2bf(acc[eb][k] * sc * bf2f(zz[k])); } }
}
#undef PDI
}

__global__ void __launch_bounds__(NWAVES * 64, 2) hymba_fwd(Args args) {
    extern __shared__ __attribute__((aligned(16))) unsigned char lds[];
    Frame F;
    F.lds = (LAS unsigned char*)lds;
    F.MISC = (volatile LAS unsigned*)(F.lds + MISC_OFF);
    F.tid = threadIdx.x; F.lane = F.tid & 63; F.wave = __builtin_amdgcn_readfirstlane(F.tid >> 6);
    F.G = gridDim.x; { const int bx = blockIdx.x; F.vcu = (F.G % 8 == 0) ? (bx % 8) * (F.G / 8) + bx / 8 : bx; }
    F.ctl = (gu32*)(args.ws + WS_CTL);
    for (int u = F.tid; u < (LDS_BYTES - LDSCTL_OFF) / 4; u += NWAVES * 64) ((LAS unsigned*)(F.lds + LDSCTL_OFF))[u] = 0u;
    __syncthreads();
    XcdBarrier bar; bar.bar = (unsigned*)(F.ctl + CW_BAR); bar.x = 0; bar.st = nullptr;
    if (N_LAUNCHES == 1) bar = xcd_barrier_post((unsigned*)(F.ctl + CW_BAR), F.MISC + 8, F.wave);
#define GRID_BAR() do { if (N_LAUNCHES == 1) xcd_barrier(bar, F.wave); } while (0)
    const int lo = args.ph_lo, hi = args.ph_hi;
#define IN(k) (lo <= (k) && (k) < hi)
#define PHASE_PTRS() kargs_t ka = (kargs_t)__builtin_amdgcn_kernarg_segment_ptr(); asm volatile("" : "+s"(ka)); unsigned char* ws = ka->ws; const float* x_prompt = (const float*)ka->in[0]; const float* x_sample = (const float*)ka->in[1]; const float* cache_cmp = (const float*)ka->in[2]; const float* cache_sel = (const float*)ka->in[3]; const float* cache_win = (const float*)ka->in[4]; const float* state_pool = (const float*)ka->in[5]; const int* page_table = (const int*)ka->in[6]; const float* norm_pre = (const float*)ka->in[7]; const float* w_in = (const float*)ka->in[8]; const float* cmp_pe = (const float*)ka->in[9]; const float* cmp_w1 = (const float*)ka->in[10]; const float* cmp_w2 = (const float*)ka->in[11]; const float* pool_w = (const float*)ka->in[12]; const float* pool_scale = (const float*)ka->in[13]; const float* gmlp_norm = (const float*)ka->in[14]; const float* gmlp_ws = (const float*)ka->in[15]; const float* gmlp_bs = (const float*)ka->in[16]; const float* w_out = (const float*)ka->in[17]; const float* norm_post = (const float*)ka->in[18]; float* out = ka->out; bf16* W1T = (bf16*)(ws + WS_W1T); bf16* W2T = (bf16*)(ws + WS_W2T); float* RS = (float*)(ws + WS_RS); float* KCP = (float*)(ws + WS_KCP); float* KCS = (float*)(ws + WS_KCS); float* GT = (float*)(ws + WS_GT); bf16* XB = (bf16*)(ws + WS_XB); bf16* MIX = (bf16*)(ws + WS_MIX); bf16* QB = (bf16*)(ws + WS_Q); bf16* ZA = (bf16*)(ws + WS_ZA); bf16* ZB = (bf16*)(ws + WS_ZB); bf16* ZC = (bf16*)(ws + WS_ZC); float* KWF = (float*)(ws + WS_KWF); float* PIN = (float*)(ws + WS_PIN); float* U = (float*)(ws + WS_U); float* V = (float*)(ws + WS_V); bf16* OUTB = (bf16*)(ws + WS_OUTF); bf16* KSB = (bf16*)(ws + WS_KSB); bf16* KWB = (bf16*)(ws + WS_KWB); (void)KSB; (void)KWB; bf16* WGB = (bf16*)(ws + WS_WGB); (void)WGB;  constexpr size_t W1T_L = (size_t)7 * MiB / 2, W2T_L = (size_t)DM * DM;
#define LAYER_PTRS() float* kc_p = out + O_KC_P + (size_t)l * MP * 256; float* kc_s = out + O_KC_S + (size_t)l * DECB * 256; float* ks_p = out + O_KS_P + (size_t)l * MP * 256; float* ks_s = out + O_KS_S + (size_t)l * DECB * 256; (void)kc_p; (void)kc_s; (void)ks_p; (void)ks_s
#define PHASE_IDS() int lane_ = (int)__builtin_amdgcn_mbcnt_hi(~0u, __builtin_amdgcn_mbcnt_lo(~0u, 0u)); asm volatile("" : "+v"(lane_)); int wv_ = F.wave, bx_ = (int)blockIdx.x, G_ = F.G; asm volatile("" : "+s"(wv_), "+s"(bx_), "+s"(G_)); const int lane = lane_, wave = wv_, bx = bx_, G = G_, tid = wave * 64 + lane, vcu = (G % 8 == 0) ? (bx % 8) * (G / 8) + bx / 8 : bx, gw = vcu * NWAVES + wave, NGW = G * NWAVES; (void)tid; (void)gw; (void)NGW
#define BOTH(k) (IN(k) && IN((k) + 1))

    if (IN(0)) {
        PHASE_IDS(); PHASE_PTRS();
        LAS float* scr = (LAS float*)(F.lds + RING_OFF + wave * 16384);
        { constexpr int NB_IN = 49, NB_OUT = 16, I_IN = NB_IN * 32, I_OUT = NB_OUT * 32, I_L = I_IN + I_OUT;
          for (int it = gw; it < DEPTH * I_L; it += NGW) {
              const int l = it / I_L; int r = it % I_L;
              const bool isIn = r < I_IN; if (!isIn) r -= I_IN;
              const int nb = r >> 5, kb = r & 31, k0 = 32 * kb, col = 64 * nb + lane;
              const int nsrc = isIn ? DIN : DM;
              const float* W = isIn ? w_in + (size_t)l * DM * DIN : w_out + (size_t)l * DM * DM;
              const float* gk = norm_pre + l * DM;
              float v[32];
              if (col < nsrc) {
#pragma unroll
                  for (int k = 0; k < 32; ++k) v[k] = W[(size_t)(k0 + k) * nsrc + col];
                  if (isIn) {
#pragma unroll
                      for (int k = 0; k < 32; ++k) v[k] *= gk[k0 + k]; }
                  const int drow = isIn ? (col < 1280 ? col : (col < 1304 ? 3072 + (col - 1280) : col - 24)) : col;
                  bf16* dst = (isIn ? W1T + l * W1T_L : W2T + l * W2T_L) + (size_t)drow * DM + k0;
#pragma unroll
                  for (int q = 0; q < 4; ++q) { v4u o; o.x = pk2(v[8 * q], v[8 * q + 1]); o.y = pk2(v[8 * q + 2], v[8 * q + 3]); o.z = pk2(v[8 * q + 4], v[8 * q + 5]); o.w = pk2(v[8 * q + 6], v[8 * q + 7]);
                      *(v4u*)(dst + 8 * q) = o; }
              }
          } }
        for (int i = gw * 64 + lane; i < DEPTH * 232 * 128; i += NGW * 64) { const int l = i / (232 * 128), r = i % (232 * 128);
            *(v4u*)(W1T + l * W1T_L + (size_t)3096 * DM + (size_t)r * 8) = (v4u){0u, 0u, 0u, 0u}; }
        for (int i8 = gw * 64 + lane; i8 < DEPTH * 4 * 128 * 128 / 8; i8 += NGW * 64) { const int e0 = i8 * 8, j0 = e0 & 127, i = (e0 >> 7) & 127;
            const f32x4 a = *(const f32x4*)(gmlp_ws + e0), b = *(const f32x4*)(gmlp_ws + e0 + 4);
            v4u o; o.x = pk2(j0 <= i ? a.x : 0.f, j0 + 1 <= i ? a.y : 0.f); o.y = pk2(j0 + 2 <= i ? a.z : 0.f, j0 + 3 <= i ? a.w : 0.f);
            o.z = pk2(j0 + 4 <= i ? b.x : 0.f, j0 + 5 <= i ? b.y : 0.f); o.w = pk2(j0 + 6 <= i ? b.z : 0.f, j0 + 7 <= i ? b.w : 0.f);
            *(v4u*)(WGB + e0) = o; }
        for (int m0 = gw; m0 < MR; m0 += 2 * NGW) { f32x4 xv[2][4];
#pragma unroll
            for (int q = 0; q < 2; ++q) { const int m = m0 + q * NGW; if (m < MR) { const f32x4* xr = (const f32x4*)(m < MP ? x_prompt + (size_t)m * DM : x_sample + (size_t)(m - MP) * DM) + lane;
#pragma unroll
                for (int j = 0; j < 4; ++j) xv[q][j] = __builtin_nontemporal_load(xr + 64 * j); } }
#pragma unroll
            for (int q = 0; q < 2; ++q) { const int m = m0 + q * NGW; if (m < MR) { float s = 0.f; v2u* o8 = (v2u*)(XB + (size_t)m * DM) + lane;
#pragma unroll
                for (int j = 0; j < 4; ++j) { const f32x4 x = xv[q][j]; s += (x.x * x.x + x.y * x.y) + (x.z * x.z + x.w * x.w); v2u w; w.x = pk2(x.x, x.y); w.y = pk2(x.z, x.w); o8[64 * j] = w; }
                s = wave_sum(s); if (lane == 0) RS[m] = s; } } }
        for (int i = gw * 64 + lane; i < MPAD; i += NGW * 64) RS[MPAD + i] = 0.f;
        {
          const size_t m4 = (size_t)DEPTH * DECB * 14 * 64;
          for (size_t i = (size_t)bx * 512 + tid; i < m4; i += (size_t)G * 512) { const size_t lb = i / (14 * 64), r = i % (14 * 64);
              *(f32x4*)(out + O_PL_S + lb * 15 * 256 + r * 4) = *(const f32x4*)(state_pool + lb * 15 * 256 + 256 + r * 4); } }
        if (BOTH(0)) GRID_BAR();
    }

#pragma unroll
    for (int l = 0; l < DEPTH; ++l) {
        const int pb = 5 * l;
        if (IN(pb + 1)) {
            int cl_ = ((int)blockIdx.x >> 3) & 3; asm volatile("" : "+s"(cl_));
#pragma nounroll
          for (int step = 0; step < 3; ++step) {
            if (step == 1) {
                PHASE_IDS(); PHASE_PTRS();
                struct JobS { const float* cache; int pagev; float* kcs; int l, bx, G;
                    __device__ __forceinline__ const float* src(int i) const { const int u = bx + i * G, n = u & 31; const int page = __builtin_amdgcn_readlane(pagev, i); return cache + (((size_t)l * NPHYS + page) * PAGE + (n & 1) * 64) * 256; }
                    __device__ __forceinline__ float* dst(int i) const { const int u = bx + i * G; return kcs + ((size_t)l * DECB * 32 + u) * 256; }
                    __device__ __forceinline__ const float* dummy() const { return kcs; } };
                const int n = (DECB * 32 - bx + G - 1) / G;
                int pagev = 0; { const int u = bx + lane * G; if (lane < n) pagev = page_table[(u >> 5) * NPAGES + ((u & 31) >> 1)]; }
                const JobS J{cache_cmp, pagev, KCS, l, bx, G};
                cmpk::run(J, n, cmp_pe + (size_t)l * 2 * 64 * 64, cmp_w1 + (size_t)l * 2 * 64 * 64, cmp_w2 + (size_t)l * 2 * 64 * 64, (LAS char*)(F.lds + RING_OFF), tid, lane, wave);
            } else {
                PHASE_IDS(); PHASE_PTRS(); LAYER_PTRS();
                struct RangeOrder { pg8::StaticOrder B; int i0, i1;
                    __device__ __forceinline__ bool next(int i, pg8::Unit& u) const { return (i0 + i < i1) && B.next(i0 + i, u); }
                    __device__ __forceinline__ void a_ready(const pg8::Unit&) const {}
                    __device__ __forceinline__ void done(const pg8::Unit&) const {} };
                pg8::Gemm g{XB, W1T + l * W1T_L, MP, 3072, DM}; RangeOrder S; S.B.init(MP, 3072, G, bx);
                S.i0 = step == 0 ? 0 : cl_; S.i1 = step == 0 ? cl_ : 3;
                pg8::EpiG1 E{ws, out, l};
                pg8::gemm_phase<pg8::EpiG1, RangeOrder, true, true>(F.lds + RING_OFF, g, S, E, wave);
            }
            __syncthreads();
          }
            PHASE_IDS(); PHASE_PTRS(); LAYER_PTRS();
            { const bf16* W1 = W1T + l * W1T_L;
              for (int u = vcu; u < 96 + 129; u += G) {
                  if (u < 96) { const int c0 = 32 * u;
                      sk::slab2(XB + (size_t)MP * DM, W1 + (size_t)c0 * DM, (LAS float*)(F.lds + RING_OFF), lane, wave, [&](int r) { return RS[(size_t)l * MPAD + MP + r]; },
                                [&](int r, int c, float v, float ssq) { sk::emit_g1_sample(ws, out, l, r, c0 + c, v * (1.f / sqrtf(ssq * (1.f / DM) + EPS))); });
                  } else { const int rb = u - 96;
                      sk::slab2(XB + (size_t)rb * 128 * DM, W1 + (size_t)3072 * DM, (LAS float*)(F.lds + RING_OFF), lane, wave, [&](int r) { return RS[(size_t)l * MPAD + rb * 128 + r]; },
                                [&](int r, int c, float v, float ssq) { const int row = rb * 128 + r;
                          if (c < 24) GT[(size_t)row * 32 + c] = pg8::sigmoidf_(v * (1.f / sqrtf(ssq * (1.f / DM) + EPS))); }); } } }
            if (BOTH(pb + 1)) GRID_BAR();
        }
        if (IN(pb + 2)) {
            int sf_ = ((int)blockIdx.x >> 3) & 1; asm volatile("" : "+s"(sf_));
#pragma nounroll
          for (int step = 0; step < 2; ++step) {
           if ((step == 0) == (sf_ != 0)) {
            PHASE_IDS(); PHASE_PTRS(); LAYER_PTRS();
            unsigned* cntSA = (unsigned*)F.ctl + pg8::CW_SEAM + (130 + l) * 64;
            const AttnPtrs A{QB, GT, KCS, ks_s, KWF, cache_sel, cache_win, page_table, ZA, MIX, cntSA};
            for (int u = bx; u < DECB * 2; u += G) sample_unit(A, l, u >> 1, u & 1, (LAS float*)(F.lds + RING_OFF), tid, lane, wave);
           } else {
            PHASE_IDS(); PHASE_PTRS(); LAYER_PTRS();
            { struct JobP { const float* kc; float* kcp; int bx, G;
                  __device__ __forceinline__ const float* src(int i) const { return kc + (size_t)(bx + i * G) * 64 * 256; }
                  __device__ __forceinline__ float* dst(int i) const { return kcp + (size_t)(bx + i * G) * 256; }
                  __device__ __forceinline__ const float* dummy() const { return kcp; } };
              const JobP J{kc_p, KCP, bx, G};
              const int n = (NB * 64 - bx + G - 1) / G;
              cmpk::run<JobP, true>(J, n, cmp_pe + (size_t)l * 2 * 64 * 64, cmp_w1 + (size_t)l * 2 * 64 * 64, cmp_w2 + (size_t)l * 2 * 64 * 64, (LAS char*)(F.lds + RING_OFF), tid, lane, wave);
              asm volatile("s_waitcnt vmcnt(0)" ::: "memory");
              __syncthreads();
              if (tid == 0) for (int i = 0; i < n; ++i) __hip_atomic_fetch_add((unsigned*)F.ctl + pg8::CW_SEAM + (132 + l * 4 + ((bx + i * G) >> 6)) * 64, 1u, __ATOMIC_RELAXED, __HIP_MEMORY_SCOPE_AGENT); }
            { LAS char* PL = (LAS char*)(F.lds + RING_OFF);
              const float* psc = pool_scale + l * 256;
              pl::stage_weights(pool_w + (size_t)l * 4 * 64 * 64, PL, tid);
              __syncthreads();
              for (int u = bx; u < MP / 64 + DECB / 32; u += G) {
                  const int ch = tid & 255, half = tid >> 8;
                  if (u < MP / 64) { const int row0 = u * 64, b = row0 >> 12, t0 = row0 & (SEQ - 1); const float* pin_b = PIN + (size_t)b * SEQ * 256;
                      switch (ch >> 6) { case 0: pl::diff_prompt<2>(pin_b, t0, ch, half, PL); break; case 1: pl::diff_prompt<4>(pin_b, t0, ch, half, PL); break;
                                         case 2: pl::diff_prompt<8>(pin_b, t0, ch, half, PL); break; default: pl::diff_prompt<16>(pin_b, t0, ch, half, PL); break; }
                      __syncthreads();
                      pl::mma_store(psc, ZB, MIX, (size_t)row0, 2, PL, lane, wave);
                  } else { const int sb0 = (u - MP / 64) * 32;
                      const float* st_l = state_pool + (size_t)l * DECB * 15 * 256;
                      switch (ch >> 6) { case 0: pl::diff_sample<2>(PIN, st_l, sb0, ch, half, PL); break; case 1: pl::diff_sample<4>(PIN, st_l, sb0, ch, half, PL); break;
                                         case 2: pl::diff_sample<8>(PIN, st_l, sb0, ch, half, PL); break; default: pl::diff_sample<16>(PIN, st_l, sb0, ch, half, PL); break; }
                      __syncthreads();
                      pl::mma_store(psc, ZB, MIX, (size_t)MP + sb0, 1, PL, lane, wave); }
                  __syncthreads();
              } }
            { const float* gn = gmlp_norm + l * 256; const float* gws = gmlp_ws + (size_t)l * 4 * 128 * 128; const float* gbs = gmlp_bs + l * 4 * 128;
              for (int u2 = bx; u2 < 2 * (MP / CHUNK); u2 += G) { const int u = u2 >> 1, row0 = u * CHUNK, b = row0 >> 12, t0 = row0 & (SEQ - 1);
                  gm::unit(V, U, ZC, MIX, gn, WGB + (size_t)l * 4 * 128 * 128, gbs, t0 == SEQ - CHUNK ? out + O_GV_P + ((size_t)l * NB + b) * CHUNK * 256 : nullptr, row0, u2 & 1, (LAS char*)(F.lds + RING_OFF), tid, lane, wave); }
              for (int it = gw; it < DECB * 4; it += NGW) { const int sb = it >> 2, g = it & 3, ch = g * 64 + lane; const size_t row = (size_t)MP + sb;
                  const float v = V[row * 256 + ch]; const float ss = wave_sum(v * v);
                  const float vn = v * (1.f / sqrtf(ss * (1.f / 64.f) + EPS)) * gn[ch];
                  out[O_GV_S + ((size_t)l * DECB + sb) * 256 + ch] = vn;
                  const float s = gws[(size_t)g * 128 * 128] * vn + gbs[g * 128];
                  MIX[row * 1024 + 768 + ch] = (bf16)f2bf(U[row * 256 + ch] * s * bf2f(ZC[row * 256 + ch])); }
            }
            if (G == 256 && (vcu < 64 || bx < 4)) {
                asm volatile("s_waitcnt vmcnt(0)" ::: "memory");
                __syncthreads();
                if (tid == 0) { __builtin_amdgcn_fence(__ATOMIC_RELEASE, "agent"); asm volatile("s_waitcnt vmcnt(0)" ::: "memory");
                    __hip_atomic_fetch_add((unsigned*)F.ctl + pg8::CW_SEAM + (140 + l) * 64, 1u, __ATOMIC_RELAXED, __HIP_MEMORY_SCOPE_AGENT); } }
           }
            __syncthreads();
          }
        }
        if (IN(pb + 3)) {
            PHASE_IDS(); PHASE_PTRS(); LAYER_PTRS();
            unsigned* cntSA = (unsigned*)F.ctl + pg8::CW_SEAM + (130 + l) * 64;
            const AttnPtrs A{QB, GT, KCS, ks_s, KWF, cache_sel, cache_win, page_table, ZA, MIX, cntSA};
            (void)A;
            const att::Ptrs AP{QB, GT, KCP, KSB, KWB, ZA, MIX};
            { const int bq = (vcu >> 6) & 3;
              if (wave == 0) { unsigned sp = 0; unsigned* ck = (unsigned*)F.ctl + pg8::CW_SEAM + (132 + l * 4 + bq) * 64;
                  while ((unsigned)__builtin_amdgcn_readfirstlane(__hip_atomic_load(ck, __ATOMIC_RELAXED, __HIP_MEMORY_SCOPE_AGENT)) < 64u) { __builtin_amdgcn_s_sleep(2); if (++sp > (1u << 16)) break; }
                  __builtin_amdgcn_fence(__ATOMIC_ACQUIRE, "agent"); }
              asm volatile("s_waitcnt vmcnt(0) lgkmcnt(0)" ::: "memory"); __syncthreads(); }
            const int sct = (int)((att::SIDE_N4 + (unsigned)G * 512u - 1u) / ((unsigned)G * 512u)), sch2 = (sct + 1) / 2;
            att::Side sd{cache_win, out + O_KW_S, l * sch2, (l == DEPTH - 1) ? sct : ((l + 1) * sch2 < sct ? (l + 1) * sch2 : sct), G, bx, 0};
            if (G == 256 && (vcu & 31) < 4) {
                if (wave == 0) { unsigned sp = 0;
                    while ((unsigned)__builtin_amdgcn_readfirstlane(__hip_atomic_load(cntSA, __ATOMIC_RELAXED, __HIP_MEMORY_SCOPE_AGENT)) < (unsigned)(DECB * 2)) { __builtin_amdgcn_s_sleep(2); if (++sp > (1u << 16)) break; }
                    { unsigned* cm = (unsigned*)F.ctl + pg8::CW_SEAM + (140 + l) * 64;
                      while ((unsigned)__builtin_amdgcn_readfirstlane(__hip_atomic_load(cm, __ATOMIC_RELAXED, __HIP_MEMORY_SCOPE_AGENT)) < 66u) { __builtin_amdgcn_s_sleep(2); if (++sp > (1u << 16)) break; } }
                    __builtin_amdgcn_fence(__ATOMIC_ACQUIRE, "agent"); }
                asm volatile("s_waitcnt vmcnt(0) lgkmcnt(0)" ::: "memory"); __syncthreads();
                const int uo = (vcu >> 5) * 4 + (vcu & 31);
                sk::sample_out(MIX + (size_t)MP * DM, W2T + l * W2T_L + (size_t)32 * uo * DM, ws, out, x_sample, norm_post + l * DM, (unsigned*)F.ctl, l, uo, (LAS float*)(F.lds + RING_OFF), tid, lane, wave);
            }
            { const int bk = vcu >> 5; unsigned* qctr = (unsigned*)F.ctl + pg8::CW_SEAM + (142 + l * 8 + bk) * 64; LAS unsigned* qw = (LAS unsigned*)(F.lds + 143360);
              for (;;) {
                  if (tid == 0) *qw = __hip_atomic_fetch_add(qctr, 1u, __ATOMIC_RELAXED, __HIP_MEMORY_SCOPE_AGENT);
                  __syncthreads();
                  const unsigned uq = (unsigned)__builtin_amdgcn_readfirstlane((int)*qw);
                  __syncthreads();
                  if (uq >= 64u) break;
                  att::unit(AP, bk >> 1, bk & 1, 63 - (int)uq, (LAS char*)(F.lds + RING_OFF), tid, lane, wave, sd); } }
            while (sd.c < sd.cend || sd.pend) att::side_step(sd, tid, wave, (LAS char*)(F.lds + RING_OFF));

            if (BOTH(pb + 3)) GRID_BAR();
        }
        if (IN(pb + 4)) {
            PHASE_IDS(); PHASE_PTRS(); LAYER_PTRS();
            pg8::Gemm g{MIX, W2T + l * W2T_L, MP, DM, DM}; pg8::StaticOrder S; S.init(MP, DM, G, bx);
            if (G == 256) {
                pg8::EpiG2F E{ws, out, x_prompt, norm_post + l * DM, (unsigned*)F.ctl, l};
                pg8::gemm_phase<pg8::EpiG2F, pg8::StaticOrder, false, true>(F.lds + RING_OFF, g, S, E, wave);
            }
            if (IN(pb + 4) && pb + 6 < hi && l + 1 < DEPTH) GRID_BAR();
        }
    }
#undef IN
#undef BOTH
}

extern "C" void kernel_launch(void* const* d_in, const int* in_sizes, int n_in, void* d_out, int out_size, void* d_ws, size_t ws_size, hipStream_t stream) {
    static int grid = 0;
    if (grid == 0) {
        if (n_in != 19 || (size_t)out_size != O_END || ws_size < WS_END) { fprintf(stderr, "kernel_launch: unexpected shapes (n_in %d, out %d, ws %zu); nothing launched\n", n_in, out_size, ws_size); grid = -1; return; }
        int dev = 0, cus = 0, per_cu = 0;
        if (hipGetDevice(&dev) != hipSuccess || hipDeviceGetAttribute(&cus, hipDeviceAttributeMultiprocessorCount, dev) != hipSuccess) { grid = -1; return; }
        if (hipFuncSetAttribute((const void*)hymba_fwd, hipFuncAttributeMaxDynamicSharedMemorySize, LDS_BYTES) != hipSuccess) { fprintf(stderr, "kernel_launch: hipFuncSetAttribute failed\n"); grid = -1; return; }
        if (hipOccupancyMaxActiveBlocksPerMultiprocessor(&per_cu, (const void*)hymba_fwd, NWAVES * 64, LDS_BYTES) != hipSuccess || per_cu < 1)
            fprintf(stderr, "kernel_launch: occupancy query reports %d workgroups per CU\n", per_cu);
        (void)hipGetLastError();
        grid = cus;
    }
    if (grid < 0) return;
    if (hipMemsetAsync((char*)d_ws + WS_CTL, 0, CTL_ZERO_BYTES, stream) != hipSuccess) return;
    Args a{};
    for (int i = 0; i < 19; ++i) a.in[i] = d_in[i];
    a.out = (float*)d_out; a.ws = (unsigned char*)d_ws;
    if (N_LAUNCHES == 1) { a.ph_lo = 0; a.ph_hi = NPHASES; hipLaunchKernelGGL(hymba_fwd, dim3(grid), dim3(NWAVES * 64), LDS_BYTES, stream, a); }
    else for (int p = 0; p < NPHASES; ++p) { a.ph_lo = p; a.ph_hi = p + 1; hipLaunchKernelGGL(hymba_fwd, dim3(grid), dim3(NWAVES * 64), LDS_BYTES, stream, a); }
}
```

```cpp
#include <hip/hip_runtime.h>
#include <cstdio>
#include <cstdint>
namespace pg8 {
#define PG8_LAS __attribute__((address_space(3)))
typedef unsigned short bf16_t;
typedef short bf16x8 __attribute__((ext_vector_type(8)));
typedef float f32x4 __attribute__((ext_vector_type(4)));
typedef unsigned u32x4 __attribute__((ext_vector_type(4)));
constexpr int BM = 256, BK = 64, HALF = 128, HTB = HALF * BK * 2  , STAGE_BYTES = 8 * HTB, NXCD = 8, WGM = 8;

__host__ __device__ __forceinline__ int lds_byte(int r, int c) { const int st = (r >> 4) * 2 + (c >> 5), rr = r & 15, cc = c & 31, ob = rr * 64 + cc * 2; return st * 1024 + (ob ^ (((ob >> 9) & 1) << 5)); }
__host__ __device__ __forceinline__ void stage_rc(int b, int& R, int& C) { const int st = b / 1024, sb = b % 1024, swz = sb ^ (((sb >> 9) & 1) << 5); R = (st >> 1) * 16 + swz / 64; C = (st & 1) * 32 + (swz % 64) / 2; }
__host__ __device__ __forceinline__ int perm32(int rho) { const int n = rho >> 4, i = rho & 15; return 8 * (i >> 2) + 4 * n + (i & 3); }

struct Unit { int pm, pn; };
struct Gemm { const bf16_t* A; const bf16_t* Bt; int M, N, K; };

struct StaticOrder {
    int nM, nN, nwg, G, c;
    __host__ __device__ void init(int M, int N, int G_, int c_) { nM = M / BM; nN = N / BM; nwg = nM * nN; G = G_; c = c_; }
    __host__ __device__ bool next(int i, Unit& u) const {
        const long L = (long)i * G + c; if (L >= nwg) return false;
        int wgid = (int)L; { const int q = nwg / NXCD, r = nwg % NXCD, xcd = wgid % NXCD, off = wgid / NXCD; wgid = (xcd < r ? xcd * (q + 1) : r * (q + 1) + (xcd - r) * q) + off; }
        const int nig = WGM * nN, gid = wgid / nig, fm = gid * WGM, gsz = (nM - fm) < WGM ? (nM - fm) : WGM;
        u.pm = fm + ((wgid % nig) % gsz); u.pn = (wgid % nig) / gsz; return true;
    }
    __device__ __forceinline__ void a_ready(const Unit&) const {}
    __device__ __forceinline__ void done(const Unit&) const {}
};
__device__ __forceinline__ unsigned cvt_pk_bf16(float lo, float hi) { unsigned r; asm volatile("v_cvt_pk_bf16_f32 %0, %1, %2" : "=v"(r) : "v"(lo), "v"(hi)); return r; }
typedef float f32x2 __attribute__((ext_vector_type(2)));
template <class Epi, class Sched, bool ALIGN_EPI = false, bool SP2 = false>
__device__ __forceinline__ void gemm_phase(PG8_LAS unsigned char* lds, const Gemm g, const Sched& S, const Epi& E, const int wave_id) {
    int lane_l = (int)__builtin_amdgcn_mbcnt_hi(~0u, __builtin_amdgcn_mbcnt_lo(~0u, 0u)); asm volatile("" : "+v"(lane_l));
    const int lane = lane_l, wid = wave_id, tid = wid * 64 + lane, wr = wid >> 2, wc = wid & 3, fr = lane & 15, fq = lane >> 4;
    const int K = g.K, nt = K / BK;
    unsigned voffA[2], voffB[2];
#pragma unroll
    for (int i = 0; i < 2; ++i) { int R, C; stage_rc(tid * 16 + i * 8192, R, C); const int Rb = Epi::PERM ? ((R & ~31) + perm32(R & 31)) : R;
        voffA[i] = (unsigned)(R * K + C) * 2u; voffB[i] = (unsigned)(Rb * K + C) * 2u; }
    const size_t kstep = (size_t)(BK * 2);
    const size_t hstep = (size_t)HALF * K * 2;
    const size_t tstep = 2 * hstep;
    const unsigned ldsw = (unsigned)wid * 1024u;
    const int aoff = lds_byte(wr * 64 + fr, fq * 8), boff = lds_byte(wc * 32 + fr, fq * 8);
#define PG8_SA(b, h) (((b) * 2 + (h)) * HTB)
#define PG8_SB(b, h) ((4 + (b) * 2 + (h)) * HTB)
#define PG8_STAGE(bufoff, gbase, voff) do { _Pragma("unroll") for (int _i = 0; _i < 2; ++_i) \
        __builtin_amdgcn_global_load_lds((const unsigned*)((const char*)(gbase) + (voff)[_i]), (PG8_LAS unsigned*)(lds + (bufoff) + ldsw + _i * 8192), 16, 0, 0); } while (0)
#define PG8_LDA(dst, b, h) do { _Pragma("unroll") for (int m = 0; m < 4; ++m) _Pragma("unroll") for (int k = 0; k < 2; ++k) dst[m][k] = *(const PG8_LAS bf16x8*)(lds + PG8_SA(b, h) + aoff + m * 2048 + k * 1024); } while (0)
#define PG8_LDB(dst, b, h) do { _Pragma("unroll") for (int n = 0; n < 2; ++n) _Pragma("unroll") for (int k = 0; k < 2; ++k) dst[n][k] = *(const PG8_LAS bf16x8*)(lds + PG8_SB(b, h) + boff + n * 2048 + k * 1024); } while (0)
#define PG8_MMA(ai, bj, At, Bt) do { __builtin_amdgcn_s_setprio(1); _Pragma("unroll") for (int m = 0; m < 4; ++m) _Pragma("unroll") for (int n = 0; n < 2; ++n) _Pragma("unroll") for (int k = 0; k < 2; ++k) \
        acc[ai][bj][m][n] = __builtin_amdgcn_mfma_f32_16x16x32_bf16(Bt[n][k], At[m][k], acc[ai][bj][m][n], 0, 0, 0); __builtin_amdgcn_s_setprio(0); } while (0)
#define PG8_WAIT_V(n) asm volatile("s_waitcnt vmcnt(" #n ")" ::: "memory")
#define PG8_WAIT_L(n) asm volatile("s_waitcnt lgkmcnt(" #n ")" ::: "memory")
#define PG8_BAR __builtin_amdgcn_s_barrier()
#define PG8_SCHED __builtin_amdgcn_sched_barrier(0)
    Unit cur, nxt; int ui = 0;
    if (!S.next(0, cur)) return;
    f32x4 acc[2][2][4][2];
#pragma unroll
    for (int a = 0; a < 2; ++a)
#pragma unroll
        for (int b = 0; b < 2; ++b)
#pragma unroll
            for (int m = 0; m < 4; ++m)
#pragma unroll
                for (int n = 0; n < 2; ++n) acc[a][b][m][n] = (f32x4){0.f, 0.f, 0.f, 0.f};
    bf16x8 At[4][2], B0[2][2], B1[2][2];
    const char* cA = (const char*)g.A + (size_t)cur.pm * tstep; const char* cB = (const char*)g.Bt + (size_t)cur.pn * tstep;
    S.a_ready(cur);
    if constexpr (SP2) {
        PG8_STAGE(PG8_SB(0, 0), cB, voffB); PG8_STAGE(PG8_SB(0, 1), cB + hstep, voffB); PG8_STAGE(PG8_SA(0, 0), cA, voffA); PG8_STAGE(PG8_SA(0, 1), cA + hstep, voffA);
        if (wr == 1) PG8_BAR;
        PG8_WAIT_V(2); PG8_BAR;
        PG8_STAGE(PG8_SB(1, 0), cB + kstep, voffB); PG8_STAGE(PG8_SA(1, 0), cA + kstep, voffA); PG8_STAGE(PG8_SB(1, 1), cB + hstep + kstep, voffB);
        PG8_WAIT_V(6); PG8_BAR;
    } else {
        PG8_STAGE(PG8_SB(0, 0), cB, voffB); PG8_STAGE(PG8_SA(0, 0), cA, voffA); PG8_STAGE(PG8_SB(0, 1), cB + hstep, voffB); PG8_STAGE(PG8_SA(0, 1), cA + hstep, voffA);
        if (wr == 1) PG8_BAR;
        PG8_WAIT_V(4); PG8_BAR;
        PG8_STAGE(PG8_SB(1, 0), cB + kstep, voffB); PG8_STAGE(PG8_SA(1, 0), cA + kstep, voffA); PG8_STAGE(PG8_SB(1, 1), cB + hstep + kstep, voffB);
        PG8_WAIT_V(6); PG8_BAR;
    }
    for (;;) {
        const bool has_next = S.next(ui + 1, nxt);
        const char* nA = has_next ? (const char*)g.A + (size_t)nxt.pm * tstep : cA; const char* nB = has_next ? (const char*)g.Bt + (size_t)nxt.pn * tstep : cB;
        for (int t = 0; t < nt; t += 2) {
            const bool last = (t == nt - 2);
            const char* a1 = cA + (size_t)(t + 1) * kstep;
            const char* a2 = last ? nA : cA + (size_t)(t + 2) * kstep; const char* b2 = last ? nB : cB + (size_t)(t + 2) * kstep;
            const char* a3 = a2 + kstep; const char* b3 = b2 + kstep;
            if (last && has_next) S.a_ready(nxt);
            if constexpr (SP2) {
            PG8_LDB(B0, 0, 0); PG8_LDB(B1, 0, 1); PG8_SCHED; PG8_LDA(At, 0, 0); PG8_STAGE(PG8_SA(1, 1), a1 + hstep, voffA);
            PG8_WAIT_V(8); PG8_WAIT_L(0); PG8_BAR; PG8_MMA(0, 0, At, B0); PG8_MMA(0, 1, At, B1); PG8_BAR; PG8_SCHED;
            PG8_LDA(At, 0, 1); PG8_STAGE(PG8_SB(0, 0), b2, voffB); PG8_STAGE(PG8_SB(0, 1), b2 + hstep, voffB); PG8_STAGE(PG8_SA(0, 0), a2, voffA);
            PG8_WAIT_V(8); PG8_WAIT_L(0); PG8_BAR; PG8_MMA(1, 0, At, B0); PG8_MMA(1, 1, At, B1); PG8_BAR; PG8_SCHED;
            PG8_LDB(B0, 1, 0); PG8_LDB(B1, 1, 1); PG8_SCHED; PG8_LDA(At, 1, 0); PG8_STAGE(PG8_SA(0, 1), a2 + hstep, voffA);
            PG8_WAIT_V(8); PG8_WAIT_L(0); PG8_BAR; PG8_MMA(0, 0, At, B0); PG8_MMA(0, 1, At, B1); PG8_BAR; PG8_SCHED;
            PG8_LDA(At, 1, 1); PG8_STAGE(PG8_SB(1, 0), b3, voffB); PG8_STAGE(PG8_SB(1, 1), b3 + hstep, voffB); PG8_STAGE(PG8_SA(1, 0), a3, voffA);
            PG8_WAIT_V(8); PG8_WAIT_L(0); PG8_BAR; PG8_MMA(1, 0, At, B0); PG8_MMA(1, 1, At, B1); PG8_BAR; PG8_SCHED;
            } else {
            PG8_LDB(B0, 0, 0); PG8_SCHED; PG8_LDA(At, 0, 0); PG8_STAGE(PG8_SA(1, 1), a1 + hstep, voffA);
            PG8_WAIT_L(8); PG8_BAR; PG8_WAIT_L(0); PG8_MMA(0, 0, At, B0); PG8_BAR; PG8_SCHED;
            PG8_LDB(B1, 0, 1); PG8_STAGE(PG8_SB(0, 0), b2, voffB);
            PG8_BAR; PG8_WAIT_L(0); PG8_MMA(0, 1, At, B1); PG8_BAR;
            PG8_LDA(At, 0, 1); PG8_STAGE(PG8_SA(0, 0), a2, voffA);
            PG8_BAR; PG8_WAIT_L(0); PG8_MMA(1, 0, At, B0); PG8_BAR; PG8_SCHED;
            PG8_STAGE(PG8_SB(0, 1), b2 + hstep, voffB);
            PG8_WAIT_V(6); PG8_BAR; PG8_MMA(1, 1, At, B1); PG8_BAR;
            PG8_LDB(B0, 1, 0); PG8_SCHED; PG8_LDA(At, 1, 0); PG8_STAGE(PG8_SA(0, 1), a2 + hstep, voffA);
            PG8_WAIT_L(8); PG8_BAR; PG8_WAIT_L(0); PG8_MMA(0, 0, At, B0); PG8_BAR; PG8_SCHED;
            PG8_LDB(B1, 1, 1); PG8_STAGE(PG8_SB(1, 0), b3, voffB);
            PG8_BAR; PG8_WAIT_L(0); PG8_MMA(0, 1, At, B1); PG8_BAR;
            PG8_LDA(At, 1, 1); PG8_STAGE(PG8_SA(1, 0), a3, voffA);
            PG8_BAR; PG8_WAIT_L(0); PG8_MMA(1, 0, At, B0); PG8_BAR; PG8_SCHED;
            PG8_STAGE(PG8_SB(1, 1), b3 + hstep, voffB);
            PG8_WAIT_V(6); PG8_BAR; PG8_MMA(1, 1, At, B1); PG8_BAR;
            }
        }
        if constexpr (ALIGN_EPI) { if (wr == 0) PG8_BAR; }
        if constexpr (!Epi::AFTER_DRAIN) { int le_ = (int)__builtin_amdgcn_mbcnt_hi(~0u, __builtin_amdgcn_mbcnt_lo(~0u, 0u)); asm volatile("" : "+v"(le_)); E(acc, cur, wr, wc, le_ & 15, le_ >> 4); S.done(cur); }
        if (!has_next) break;
#pragma unroll
        for (int a = 0; a < 2; ++a)
#pragma unroll
            for (int b = 0; b < 2; ++b)
#pragma unroll
                for (int m = 0; m < 4; ++m)
#pragma unroll
                    for (int n = 0; n < 2; ++n) acc[a][b][m][n] = (f32x4){0.f, 0.f, 0.f, 0.f};
        cur = nxt; cA = nA; cB = nB; ++ui;
        if constexpr (ALIGN_EPI) { if (wr == 1) PG8_BAR; }
    }
    PG8_WAIT_V(0);
    if constexpr (!ALIGN_EPI) { if (wr == 0) PG8_BAR; }
    PG8_BAR;
    if constexpr (Epi::AFTER_DRAIN) { int le_ = (int)__builtin_amdgcn_mbcnt_hi(~0u, __builtin_amdgcn_mbcnt_lo(~0u, 0u)); asm volatile("" : "+v"(le_)); E.fused(acc, cur, wr, wc, le_ & 15, le_ >> 4, lds, wid, le_); S.done(cur); }
#undef PG8_SA
#undef PG8_SB
#undef PG8_STAGE
#undef PG8_LDA
#undef PG8_LDB
#undef PG8_MMA
#undef PG8_WAIT_V
#undef PG8_WAIT_L
#undef PG8_BAR
#undef PG8_SCHED
}

constexpr size_t G1_MiB = 1u << 20;
constexpr size_t G1_RS = 20 * G1_MiB, G1_GT = 30 * G1_MiB, G1_Q = 102 * G1_MiB, G1_ZA = 120 * G1_MiB, G1_ZB = 138 * G1_MiB, G1_ZC = 148 * G1_MiB, G1_KWF = 158 * G1_MiB, G1_PIN = 176 * G1_MiB, G1_U = 194 * G1_MiB, G1_V = 212 * G1_MiB, G1_KSB = 362 * G1_MiB, G1_KWB = 372 * G1_MiB;
constexpr size_t G1_O_KC_P = 16908288, G1_O_KC_S = 25296896, G1_O_KS_P = 25362432, G1_O_KS_S = 33751040, G1_O_KW_P = 33816576, G1_O_KW_S = 34865152, G1_O_PL_P = 68419584, G1_O_PL_S = 68450304;
constexpr int E_MP = 16384, E_MR = 16512, E_SEQ = 4096, G1_MPAD = 16640;
constexpr size_t G1_XB = 34 * G1_MiB, G1_XS = 230 * G1_MiB;
constexpr int CW_SEAM = 8192;
constexpr float QSCALE = 0.125f * 1.4426950408889634f;
__device__ __forceinline__ float sigmoidf_(float x) { return __builtin_amdgcn_rcpf(1.f + __builtin_amdgcn_exp2f(-1.4426950408889634f * x)); }
__device__ __forceinline__ u32x4 pack8(f32x4 a, f32x4 b) { u32x4 w; w.x = cvt_pk_bf16(a[0], a[1]); w.y = cvt_pk_bf16(a[2], a[3]); w.z = cvt_pk_bf16(b[0], b[1]); w.w = cvt_pk_bf16(b[2], b[3]); return w; }
__device__ __forceinline__ f32x4 silu4(f32x4 v) { f32x4 r; r[0] = v[0] * sigmoidf_(v[0]); r[1] = v[1] * sigmoidf_(v[1]); r[2] = v[2] * sigmoidf_(v[2]); r[3] = v[3] * sigmoidf_(v[3]); return r; }

struct EpiG1 {
    static constexpr bool PERM = true, AFTER_DRAIN = false;
    unsigned char* ws; float* out; int l;
    template <int KIND> __device__ __forceinline__ void tile(const f32x4 (&acc)[2][2][4][2], const Unit& u, int wr, int wc, int fr, int fq) const {
        const int row0 = u.pm * BM + wr * 64 + fr;
        const float* RS = (const float*)(ws + G1_RS); bf16_t* Q = (bf16_t*)(ws + G1_Q); float* KWF = (float*)(ws + G1_KWF); bf16_t* ZA = (bf16_t*)(ws + G1_ZA); float* PIN = (float*)(ws + G1_PIN);
        bf16_t* ZB = (bf16_t*)(ws + G1_ZB); float* U = (float*)(ws + G1_U); float* V = (float*)(ws + G1_V); bf16_t* ZC = (bf16_t*)(ws + G1_ZC); float* GT = (float*)(ws + G1_GT);
        float* kc_p = out + G1_O_KC_P + (size_t)l * E_MP * 256; float* kc_s = out + G1_O_KC_S + (size_t)l * 128 * 256; float* ks_p = out + G1_O_KS_P + (size_t)l * E_MP * 256; float* ks_s = out + G1_O_KS_S + (size_t)l * 128 * 256;
        float* kw_p = out + G1_O_KW_P + (size_t)l * 4 * 512 * 256; float* kw_s = out + G1_O_KW_S + (size_t)l * 128 * 512 * 256; float* pool_p = out + G1_O_PL_P + (size_t)l * 4 * 15 * 256; float* pool_s = out + G1_O_PL_S + (size_t)l * 128 * 15 * 256;
        float ssq[2][4];
#pragma unroll
        for (int ai = 0; ai < 2; ++ai)
#pragma unroll
            for (int m = 0; m < 4; ++m) ssq[ai][m] = RS[(size_t)l * G1_MPAD + row0 + ai * HALF + m * 16];
#pragma unroll
        for (int ai = 0; ai < 2; ++ai)
#pragma unroll
            for (int m = 0; m < 4; ++m) {
                const int row = row0 + ai * HALF + m * 16;
                if (row < E_MR) {
                    const float rs = 1.f / sqrtf(ssq[ai][m] * (1.f / 1024.f) + 1e-6f);
                    const bool isP = row < E_MP; const int b = row >> 12, t = row & (E_SEQ - 1), sb = row - E_MP;
#pragma unroll
                    for (int bj = 0; bj < 2; ++bj) {
                        const int col = wc * 32 + 8 * fq + bj * HALF;
                        f32x4 v0 = acc[ai][bj][m][0] * rs, v1 = acc[ai][bj][m][1] * rs;
                        if constexpr (KIND == 0) {
                            *(u32x4*)(Q + (size_t)row * 512 + u.pn * 256 + col) = pack8(v0 * QSCALE, v1 * QSCALE);
                        } else if constexpr (KIND == 1) {
                            float* d = isP ? kc_p + (size_t)row * 256 : kc_s + (size_t)sb * 256; *(f32x4*)(d + col) = v0; *(f32x4*)(d + col + 4) = v1;
                        } else if constexpr (KIND == 2) {
                            float* d = isP ? ks_p + (size_t)row * 256 : ks_s + (size_t)sb * 256; __builtin_nontemporal_store(v0, (f32x4*)(d + col)); __builtin_nontemporal_store(v1, (f32x4*)(d + col + 4));
                            *(u32x4*)((bf16_t*)(ws + G1_KSB) + (size_t)row * 256 + col) = pack8(v0, v1);
                        } else if constexpr (KIND == 3) {
                            *(u32x4*)((bf16_t*)(ws + G1_KWB) + (size_t)row * 256 + col) = pack8(v0, v1);
                            float* e = nullptr;
                            if (isP) { if (t >= E_SEQ - 512) e = kw_p + ((size_t)b * 512 + (t - (E_SEQ - 512))) * 256; } else e = kw_s + ((size_t)sb * 512 + 511) * 256;
                            if (e) { *(f32x4*)(e + col) = v0; *(f32x4*)(e + col + 4) = v1; }
                        } else if constexpr (KIND == 4) {
                            *(u32x4*)(ZA + (size_t)row * 512 + (u.pn - 5) * 256 + col) = pack8(silu4(v0), silu4(v1));
                        } else if constexpr (KIND == 5) {
                            float* d = PIN + (size_t)row * 256; *(f32x4*)(d + col) = v0; *(f32x4*)(d + col + 4) = v1;
                            float* e = nullptr;
                            if (isP) { if (t >= E_SEQ - 15) e = pool_p + ((size_t)b * 15 + (t - (E_SEQ - 15))) * 256; } else e = pool_s + ((size_t)sb * 15 + 14) * 256;
                            if (e) { *(f32x4*)(e + col) = v0; *(f32x4*)(e + col + 4) = v1; }
                        } else if constexpr (KIND == 6) {
                            *(u32x4*)(ZB + (size_t)row * 256 + col) = pack8(silu4(v0), silu4(v1));
                        } else if constexpr (KIND == 7) {
                            float* d = U + (size_t)row * 256; *(f32x4*)(d + col) = v0; *(f32x4*)(d + col + 4) = v1;
                        } else if constexpr (KIND == 8) {
                            float* d = V + (size_t)row * 256; *(f32x4*)(d + col) = v0; *(f32x4*)(d + col + 4) = v1;
                        } else if constexpr (KIND == 9) {
                            *(u32x4*)(ZC + (size_t)row * 256 + col) = pack8(silu4(v0), silu4(v1));
                        } else {
                            if (col < 24) { float* d = GT + (size_t)row * 32 + col; f32x4 g0, g1;
                                for (int i = 0; i < 4; ++i) { g0[i] = sigmoidf_(v0[i]); g1[i] = sigmoidf_(v1[i]); }
                                *(f32x4*)d = g0; *(f32x4*)(d + 4) = g1; }
                        }
                    }
                }
            }
    }
    __device__ __forceinline__ void operator()(const f32x4 (&acc)[2][2][4][2], const Unit& u, int wr, int wc, int fr, int fq) const {
        asm volatile("" : "+v"(fr), "+v"(fq));
        switch (u.pn) {
            case 0: case 1: tile<0>(acc, u, wr, wc, fr, fq); break;
            case 2: tile<1>(acc, u, wr, wc, fr, fq); break;
            case 3: tile<2>(acc, u, wr, wc, fr, fq); break;
            case 4: tile<3>(acc, u, wr, wc, fr, fq); break;
            case 5: case 6: tile<4>(acc, u, wr, wc, fr, fq); break;
            case 7: tile<5>(acc, u, wr, wc, fr, fq); break;
            case 8: tile<6>(acc, u, wr, wc, fr, fq); break;
            case 9: tile<7>(acc, u, wr, wc, fr, fq); break;
            case 10: tile<8>(acc, u, wr, wc, fr, fq); break;
            case 11: tile<9>(acc, u, wr, wc, fr, fq); break;
            default: tile<10>(acc, u, wr, wc, fr, fq); break;
        }
    }
};
struct EpiG2 {
    static constexpr bool PERM = true, AFTER_DRAIN = false;
    bf16_t* O;
    __device__ __forceinline__ void operator()(const f32x4 (&acc)[2][2][4][2], const Unit& u, int wr, int wc, int fr, int fq) const {
        asm volatile("" : "+v"(fr), "+v"(fq));
        const int row0 = u.pm * BM + wr * 64 + fr;
#pragma unroll
        for (int ai = 0; ai < 2; ++ai)
#pragma unroll
            for (int m = 0; m < 4; ++m) {
                const int row = row0 + ai * HALF + m * 16;
                if (row < E_MR) {
#pragma unroll
                    for (int bj = 0; bj < 2; ++bj) { bf16_t* d = O + (size_t)row * 1024 + u.pn * BM + wc * 32 + 8 * fq + bj * HALF; *(u32x4*)d = pack8(acc[ai][bj][m][0], acc[ai][bj][m][1]); }
                }
            }
    }
};
struct EpiG2F {
    static constexpr bool PERM = true, AFTER_DRAIN = true;
    unsigned char* ws; float* out; const float* xin; const float* gpost; unsigned* ctl; int l;
    __device__ __forceinline__ void fused(f32x4 (&acc)[2][2][4][2], const Unit& u, int wr, int wc, int fr, int fq, PG8_LAS unsigned char* lds, int wid, int lane) const {
        u32x4 preb[4][2];
        { bf16_t* XBp = (bf16_t*)(ws + G1_XB);
#pragma unroll
          for (int m = 0; m < 4; ++m) { const size_t row = (size_t)u.pm * BM + wr * 64 + m * 16 + fr;
#pragma unroll
              for (int bj = 0; bj < 2; ++bj) { const int col = u.pn * BM + wc * 32 + 8 * fq + bj * HALF;
                  preb[m][bj] = *(const u32x4*)(XBp + row * 1024 + col); } } }
        PG8_LAS float* P = (PG8_LAS float*)lds;
        PG8_LAS float* S = P + 1024;
        PG8_LAS unsigned* flag = (PG8_LAS unsigned*)(S + 256);
        const int tid = wid * 64 + lane;
#pragma unroll
        for (int ai = 0; ai < 2; ++ai)
#pragma unroll
            for (int m = 0; m < 4; ++m) { float s = 0.f;
#pragma unroll
                for (int bj = 0; bj < 2; ++bj)
#pragma unroll
                    for (int n = 0; n < 2; ++n) { const f32x4 x = acc[ai][bj][m][n]; s += (x[0] * x[0] + x[1] * x[1]) + (x[2] * x[2] + x[3] * x[3]); }
                s += __builtin_bit_cast(float, __builtin_amdgcn_ds_swizzle(__builtin_bit_cast(int, s), 0x401F));
                { auto rr = __builtin_amdgcn_permlane32_swap(__float_as_uint(s), __float_as_uint(s), false, false); s = __uint_as_float(rr[0]) + __uint_as_float(rr[1]); }
                if (fq == 0) P[(ai * HALF + wr * 64 + m * 16 + fr) * 4 + wc] = s; }
        asm volatile("s_waitcnt lgkmcnt(0)" ::: "memory"); __builtin_amdgcn_s_barrier(); asm volatile("" ::: "memory");
        float* slots = (float*)(ws + G1_XS) + (size_t)l * E_MP * 4;
        unsigned* cnt = ctl + CW_SEAM + (l * 65 + u.pm) * 64;
        if (tid < 256) { const float st = (P[tid * 4] + P[tid * 4 + 1]) + (P[tid * 4 + 2] + P[tid * 4 + 3]);
            __hip_atomic_store(slots + (size_t)(u.pm * BM + tid) * 4 + u.pn, st, __ATOMIC_RELAXED, __HIP_MEMORY_SCOPE_AGENT); }
        asm volatile("s_waitcnt vmcnt(0)" ::: "memory"); __builtin_amdgcn_s_barrier(); asm volatile("" ::: "memory");
        if (tid == 0) __hip_atomic_fetch_add(cnt, 1u, __ATOMIC_RELAXED, __HIP_MEMORY_SCOPE_AGENT);
        if (wid == 0) { bool dead = false; unsigned sp = 0;
            while ((unsigned)__builtin_amdgcn_readfirstlane(__hip_atomic_load(cnt, __ATOMIC_RELAXED, __HIP_MEMORY_SCOPE_AGENT)) < 4u) { __builtin_amdgcn_s_sleep(2); if (++sp > (1u << 16)) { dead = true; break; } }
            __builtin_amdgcn_fence(__ATOMIC_ACQUIRE, "agent");
            if (lane == 0) flag[0] = dead ? 1u : 0u; }
        asm volatile("s_waitcnt vmcnt(0) lgkmcnt(0)" ::: "memory"); __builtin_amdgcn_s_barrier(); asm volatile("" ::: "memory");
        if (tid < 256) { const float* sl = slots + (size_t)(u.pm * BM + tid) * 4; float ss = 0.f;
#pragma unroll
            for (int t = 0; t < 4; ++t) ss += __hip_atomic_load(sl + t, __ATOMIC_RELAXED, __HIP_MEMORY_SCOPE_AGENT);
            S[tid] = flag[0] ? __builtin_nanf("") : 1.f / sqrtf(ss * (1.f / 1024.f) + 1e-6f); }
        asm volatile("s_waitcnt vmcnt(0) lgkmcnt(0)" ::: "memory"); __builtin_amdgcn_s_barrier(); asm volatile("" ::: "memory");
        bf16_t* XB = (bf16_t*)(ws + G1_XB); float* RSN = (float*)(ws + G1_RS) + G1_MPAD;
        f32x4 gq[2][2];
#pragma unroll
        for (int bj = 0; bj < 2; ++bj) { const int col = u.pn * BM + wc * 32 + 8 * fq + bj * HALF; gq[bj][0] = *(const f32x4*)(gpost + col); gq[bj][1] = *(const f32x4*)(gpost + col + 4); }
#pragma unroll
        for (int ai = 0; ai < 2; ++ai) {
            if (ai == 1) {
#pragma unroll
                for (int m = 0; m < 4; ++m) { const size_t row = (size_t)u.pm * BM + HALF + wr * 64 + m * 16 + fr;
#pragma unroll
                    for (int bj = 0; bj < 2; ++bj) { const int col = u.pn * BM + wc * 32 + 8 * fq + bj * HALF; preb[m][bj] = *(const u32x4*)(XB + row * 1024 + col); } }
                __builtin_amdgcn_sched_barrier(0);
            }
#pragma unroll
            for (int m = 0; m < 4; ++m) { const int rl = ai * HALF + wr * 64 + m * 16 + fr; const size_t row = (size_t)u.pm * BM + rl; const float r = S[rl]; float q = 0.f;
#pragma unroll
                for (int bj = 0; bj < 2; ++bj) { const int col = u.pn * BM + wc * 32 + 8 * fq + bj * HALF;
                    const f32x4 g0 = gq[bj][0], g1 = gq[bj][1]; f32x4 x0, x1;
                    { const u32x4 w = preb[m][bj];
                        x0 = (f32x4){__uint_as_float(w.x << 16), __uint_as_float(w.x & 0xffff0000u), __uint_as_float(w.y << 16), __uint_as_float(w.y & 0xffff0000u)};
                        x1 = (f32x4){__uint_as_float(w.z << 16), __uint_as_float(w.z & 0xffff0000u), __uint_as_float(w.w << 16), __uint_as_float(w.w & 0xffff0000u)}; }
                    const f32x4 y0 = x0 + acc[ai][bj][m][0] * r * g0, y1 = x1 + acc[ai][bj][m][1] * r * g1;
                    if (l == 0) { *(u32x4*)(XB + row * 1024 + col) = pack8(y0, y1);
                        q += ((y0[0] * y0[0] + y0[1] * y0[1]) + (y0[2] * y0[2] + y0[3] * y0[3])) + ((y1[0] * y1[0] + y1[1] * y1[1]) + (y1[2] * y1[2] + y1[3] * y1[3])); }
                    else { float* d = out + row * 1024 + col; __builtin_nontemporal_store(y0, (f32x4*)d); __builtin_nontemporal_store(y1, (f32x4*)(d + 4)); } }
                if (l == 0) { q += __builtin_bit_cast(float, __builtin_amdgcn_ds_swizzle(__builtin_bit_cast(int, q), 0x401F));
                    { auto rr = __builtin_amdgcn_permlane32_swap(__float_as_uint(q), __float_as_uint(q), false, false); q = __uint_as_float(rr[0]) + __uint_as_float(rr[1]); }
                    if (fq == 0) __hip_atomic_fetch_add(RSN + row, q, __ATOMIC_RELAXED, __HIP_MEMORY_SCOPE_AGENT); } }
        }
    }
};
}

constexpr int NWAVES = 8;
constexpr int DM = 1024, NB = 4, SEQ = 4096, DEPTH = 2, DECB = 128, PAST = 2048, PAGE = 128, NPAGES = PAST / PAGE, NPHYS = 2560;
constexpr int MP = NB * SEQ, MR = MP + DECB, MPAD = 16640;
constexpr int DIN = 3096, N1 = 3328;
constexpr int WINDOW = 512, POOLR = 15, CHUNK = 128;
constexpr float EPS = 1e-6f, LOG2E = 1.4426950408889634f;
static_assert(MP == pg8::E_MP && MR == pg8::E_MR && SEQ == pg8::E_SEQ, "epilogue constants");
constexpr int NPHASES = 11;
#ifndef MK_N_LAUNCHES
#define MK_N_LAUNCHES 1
#endif
constexpr int N_LAUNCHES = MK_N_LAUNCHES;
static_assert(N_LAUNCHES == 1 || N_LAUNCHES == NPHASES, "launch cuts");

constexpr size_t O_Y_P = 0, O_Y_S = O_Y_P + (size_t)MP * DM, O_KC_P = O_Y_S + (size_t)DECB * DM, O_KC_S = O_KC_P + (size_t)DEPTH * MP * 256,
    O_KS_P = O_KC_S + (size_t)DEPTH * DECB * 256, O_KS_S = O_KS_P + (size_t)DEPTH * MP * 256, O_KW_P = O_KS_S + (size_t)DEPTH * DECB * 256,
    O_KW_S = O_KW_P + (size_t)DEPTH * NB * 512 * 256, O_PL_P = O_KW_S + (size_t)DEPTH * DECB * 512 * 256, O_PL_S = O_PL_P + (size_t)DEPTH * NB * 15 * 256,
    O_GV_P = O_PL_S + (size_t)DEPTH * DECB * 15 * 256, O_GV_S = O_GV_P + (size_t)DEPTH * NB * 128 * 256, O_END = O_GV_S + (size_t)DEPTH * DECB * 256;
static_assert(O_END == 69761024, "output size");
static_assert(O_KC_P == pg8::G1_O_KC_P && O_KC_S == pg8::G1_O_KC_S && O_KS_P == pg8::G1_O_KS_P && O_KS_S == pg8::G1_O_KS_S && O_KW_P == pg8::G1_O_KW_P && O_KW_S == pg8::G1_O_KW_S && O_PL_P == pg8::G1_O_PL_P && O_PL_S == pg8::G1_O_PL_S, "epilogue output offsets");

constexpr size_t MiB = 1u << 20;
constexpr size_t WS_CTL = 0, CTL_ZERO_BYTES = 128 * 1024;
constexpr size_t WS_W1T = 2 * MiB;
constexpr size_t WS_W2T = 16 * MiB;
constexpr size_t WS_RS = 20 * MiB;
constexpr size_t WS_KCP = 21 * MiB;
constexpr size_t WS_KCS = 22 * MiB;
constexpr size_t WS_GT = 30 * MiB;
constexpr size_t WS_XB = 34 * MiB;
constexpr size_t WS_MIX = 68 * MiB;
constexpr size_t WS_Q = 102 * MiB;
constexpr size_t WS_ZA = 120 * MiB;
constexpr size_t WS_ZB = 138 * MiB;
constexpr size_t WS_ZC = 148 * MiB;
constexpr size_t WS_KWF = 158 * MiB;
constexpr size_t WS_PIN = 176 * MiB;
constexpr size_t WS_U = 194 * MiB;
constexpr size_t WS_V = 212 * MiB;
constexpr size_t WS_XF = 230 * MiB;
constexpr size_t WS_OUTF = 296 * MiB;
constexpr size_t WS_KSB = 362 * MiB;
constexpr size_t WS_KWB = 372 * MiB;
constexpr size_t WS_WGB = 382 * MiB;
constexpr size_t WS_END = 384 * MiB;
static_assert(WS_XB == pg8::G1_XB && WS_XF == pg8::G1_XS && MPAD == pg8::G1_MPAD && (pg8::CW_SEAM + 142 * 64) * 4 <= (int)CTL_ZERO_BYTES && WS_RS == pg8::G1_RS && WS_GT == pg8::G1_GT && WS_Q == pg8::G1_Q && WS_ZA == pg8::G1_ZA && WS_ZB == pg8::G1_ZB && WS_ZC == pg8::G1_ZC && WS_KWF == pg8::G1_KWF && WS_PIN == pg8::G1_PIN && WS_U == pg8::G1_U && WS_V == pg8::G1_V && WS_KSB == pg8::G1_KSB && WS_KWB == pg8::G1_KWB, "epilogue workspace offsets");
constexpr int CW_BAR = 4096;

constexpr int RING_OFF = 0, RING_BYTES = 131072;
constexpr int LDSCTL_OFF = RING_BYTES, MISC_OFF = LDSCTL_OFF + 320;
constexpr int LDS_BYTES = 147456;

#define GAS __attribute__((address_space(1)))
#define LAS __attribute__((address_space(3)))
typedef unsigned short bf16;
typedef unsigned v4u __attribute__((ext_vector_type(4)));
typedef unsigned v2u __attribute__((ext_vector_type(2)));
typedef float f32x4 __attribute__((ext_vector_type(4)));
typedef GAS unsigned gu32;
#define RLX_AGENT __ATOMIC_RELAXED, __HIP_MEMORY_SCOPE_AGENT
#define LDS_WAIT() asm volatile("s_waitcnt lgkmcnt(0)" ::: "memory")
#define VM_WAIT() asm volatile("s_waitcnt vmcnt(0)" ::: "memory")
typedef __bf16 hw_bf16x2 __attribute__((ext_vector_type(2)));
typedef float hw_f32x2 __attribute__((ext_vector_type(2)));
__device__ __forceinline__ unsigned pk2(float lo, float hi) { hw_f32x2 v = {lo, hi}; hw_bf16x2 b = __builtin_convertvector(v, hw_bf16x2); return __builtin_bit_cast(unsigned, b); }
__device__ __forceinline__ unsigned f2bf(float f) { return pk2(f, 0.f) & 0xffffu; }
__device__ __forceinline__ float bf2f(unsigned short h) { return __builtin_bit_cast(float, (unsigned)h << 16); }
__device__ __forceinline__ int lane_l() { int l = (int)__builtin_amdgcn_mbcnt_hi(~0u, __builtin_amdgcn_mbcnt_lo(~0u, 0u)); asm volatile("" : "+v"(l)); return l; }
__device__ __forceinline__ float shx(float v, int idx4) { return __builtin_bit_cast(float, __builtin_amdgcn_ds_bpermute(idx4, __builtin_bit_cast(int, v))); }
__device__ __forceinline__ unsigned shxu(unsigned v, int idx4) { return (unsigned)__builtin_amdgcn_ds_bpermute(idx4, (int)v); }
template <int CTRL> __device__ __forceinline__ float dppf(float v) { return __builtin_bit_cast(float, __builtin_amdgcn_update_dpp(0, __builtin_bit_cast(int, v), CTRL, 0xF, 0xF, true)); }
__device__ __forceinline__ float swz16(float v) { return __builtin_bit_cast(float, __builtin_amdgcn_ds_swizzle(__builtin_bit_cast(int, v), 0x401F)); }
__device__ __forceinline__ float wave_sum(float v) {
    v += dppf<0xB1>(v); v += dppf<0x4E>(v); v += dppf<0x141>(v); v += dppf<0x140>(v); v += swz16(v);
    auto rr = __builtin_amdgcn_permlane32_swap(__float_as_uint(v), __float_as_uint(v), false, false); return __uint_as_float(rr[0]) + __uint_as_float(rr[1]);
}
__device__ __forceinline__ float wave_max(float v) {
    v = fmaxf(v, dppf<0xB1>(v)); v = fmaxf(v, dppf<0x4E>(v)); v = fmaxf(v, dppf<0x141>(v)); v = fmaxf(v, dppf<0x140>(v)); v = fmaxf(v, swz16(v));
    auto rr = __builtin_amdgcn_permlane32_swap(__float_as_uint(v), __float_as_uint(v), false, false); return fmaxf(__uint_as_float(rr[0]), __uint_as_float(rr[1]));
}
__device__ __forceinline__ float rdlane(float v, int i) { return __builtin_bit_cast(float, __builtin_amdgcn_readlane(__builtin_bit_cast(int, v), i)); }
__device__ __forceinline__ float siluf_(float x) { return x * __builtin_amdgcn_rcpf(1.f + __builtin_amdgcn_exp2f(-1.4426950408889634f * x)); }

#define XB_TMO      128
#define XB_XCNT(j)  (256  + 64 * (j))
#define XB_XSUB(j)  (1280 + 64 * (j))
#define XB_XGEN(j)  (2304 + 64 * (j))
#define XB_TOP      3328
#define XB_TOPGEN   3392
#define XCD_BAR_WORDS 3456
#define XB_SPIN_CAP (1u << 18)

__device__ __forceinline__ unsigned xb_ld(unsigned* p)              { return __hip_atomic_load(p, __ATOMIC_RELAXED, __HIP_MEMORY_SCOPE_AGENT); }
__device__ __forceinline__ unsigned xb_add(unsigned* p, unsigned v) { return __hip_atomic_fetch_add(p, v, __ATOMIC_RELAXED, __HIP_MEMORY_SCOPE_AGENT); }
__device__ __forceinline__ unsigned xb_xcc_id() { return (unsigned)__builtin_amdgcn_s_getreg((3 << 11) | 20) & 0xFu; }
#define XB_SPIN(cond, bar) do { unsigned _sp = 0; while (cond) { __builtin_amdgcn_s_sleep(1); \
    if ((++_sp & 255u) == 0u) { if (xb_ld(&(bar)[XB_TMO])) break; if (_sp > XB_SPIN_CAP) { atomicAdd(&(bar)[XB_TMO], 1u); break; } } } } while (0)

struct XcdBarrier {
    unsigned* bar; unsigned x;
    volatile LAS unsigned* st;
};

__device__ __forceinline__ bool xb_thread0(int wave) { unsigned ln = __builtin_amdgcn_mbcnt_hi(~0u, __builtin_amdgcn_mbcnt_lo(~0u, 0u)); asm volatile("" : "+v"(ln)); return wave == 0 && ln == 0u; }
__device__ __forceinline__ XcdBarrier xcd_barrier_post(unsigned* bar, volatile LAS unsigned* st, int wave) {
    XcdBarrier b; b.bar = bar; b.x = xb_xcc_id(); b.st = st;
    if (xb_thread0(wave)) (void)xb_add(&bar[XB_XCNT(b.x)], 1u);
    return b;
}
__device__ __forceinline__ void xcd_barrier_complete(unsigned* bar, unsigned x, unsigned& nloc, unsigned& nx) {
    const unsigned G = gridDim.x * gridDim.y * gridDim.z;
    unsigned sum, cnt, mine, sp = 0u;
    for (;;) {
        sum = 0u; cnt = 0u; mine = 0u;
#pragma unroll
        for (unsigned j = 0; j < 16; ++j) { const unsigned c = xb_ld(&bar[XB_XCNT(j)]); sum += c; cnt += (c > 0u) ? 1u : 0u; mine = (j == x) ? c : mine; }
        if (sum == G) break;
        __builtin_amdgcn_s_sleep(1);
        if ((++sp & 255u) == 0u) { if (xb_ld(&bar[XB_TMO])) break; if (sp > XB_SPIN_CAP) { atomicAdd(&bar[XB_TMO], 1u); break; } }
    }
    nloc = mine > 0u ? mine : 1u; nx = cnt > 0u ? cnt : 1u;
}

__device__ __forceinline__ void xcd_barrier(const XcdBarrier& b, int wave) {
    asm volatile("s_waitcnt vmcnt(0)" ::: "memory");
    __syncthreads();
    if (xb_thread0(wave)) {
        unsigned* bar = b.bar; asm volatile("" : "+s"(bar));
        __builtin_amdgcn_s_waitcnt(0);
        unsigned nloc = b.st[0], nx = b.st[1];
        if (nloc == 0u) { xcd_barrier_complete(bar, b.x, nloc, nx); b.st[0] = nloc; b.st[1] = nx; }
        const unsigned old = xb_add(&bar[XB_XSUB(b.x)], 1u);
        const unsigned gen = old / nloc;
        if (old + 1u == (gen + 1u) * nloc) {
            __builtin_amdgcn_fence(__ATOMIC_RELEASE, "agent");
            asm volatile("s_waitcnt vmcnt(0)" ::: "memory");
            const unsigned og = xb_add(&bar[XB_TOP], 1u);
            const unsigned tg = og / nx;
            if (og + 1u == (tg + 1u) * nx) xb_add(&bar[XB_TOPGEN], 1u);
            else XB_SPIN(xb_ld(&bar[XB_TOPGEN]) == tg, bar);
            __builtin_amdgcn_fence(__ATOMIC_ACQUIRE, "agent");
            xb_add(&bar[XB_XGEN(b.x)], 1u);
            asm volatile("s_waitcnt vmcnt(0)" ::: "memory");
        } else {
            XB_SPIN(xb_ld(&bar[XB_XGEN(b.x)]) == gen, bar);
            __builtin_amdgcn_fence(__ATOMIC_ACQUIRE, "agent");
            asm volatile("s_waitcnt vmcnt(0)" ::: "memory");
        }
    }
    __syncthreads();
}

struct Args { const void* in[19]; float* out; unsigned char* ws; int ph_lo, ph_hi; };
typedef const __attribute__((address_space(4))) struct Args* kargs_t;
struct Frame {
    LAS unsigned char* lds;
    volatile LAS unsigned* MISC;
    gu32* ctl;
    int tid, lane, wave, vcu, G;
};

__device__ __forceinline__ void transpose_item(const float* W, int Nsrc, int k0, int n_src0, int n_valid, const float* gk, bf16* WT, int dst_row0, int K, LAS float* scr, int lane) {
#pragma unroll 8
    for (int i = 0; i < 32; ++i) { const int kk = 2 * i + (lane >> 5), c = lane & 31;
        float w = (c < n_valid) ? W[(size_t)(k0 + kk) * Nsrc + n_src0 + c] : 0.f; if (gk) w *= gk[k0 + kk];
        scr[kk * 33 + c] = w; }
    LDS_WAIT(); asm volatile("" ::: "memory");
    const int c = lane & 7;
#pragma unroll
    for (int j = 0; j < 4; ++j) { const int n = (lane >> 3) + 8 * j; const LAS float* s = scr + (8 * c) * 33 + n;
        v4u o; o.x = pk2(s[0 * 33], s[1 * 33]); o.y = pk2(s[2 * 33], s[3 * 33]); o.z = pk2(s[4 * 33], s[5 * 33]); o.w = pk2(s[6 * 33], s[7 * 33]);
        *(v4u*)(WT + (size_t)(dst_row0 + n) * K + k0 + 8 * c) = o; }
    LDS_WAIT(); asm volatile("" ::: "memory");
}
__device__ __forceinline__ void row_to_bf16(const float* xrow, bf16* orow, float* rs, int lane) {
    const f32x4* xr = (const f32x4*)xrow + lane;
    f32x4 v[4]; float s = 0.f;
#pragma unroll
    for (int j = 0; j < 4; ++j) { v[j] = xr[64 * j]; s += (v[j].x * v[j].x + v[j].y * v[j].y) + (v[j].z * v[j].z + v[j].w * v[j].w); }
    s = wave_sum(s);
    v2u* o8 = (v2u*)orow + lane;
#pragma unroll
    for (int j = 0; j < 4; ++j) { v2u w; w.x = pk2(v[j].x, v[j].y); w.y = pk2(v[j].z, v[j].w); o8[64 * j] = w; }
    if (lane == 0) *rs = 1.f / sqrtf(s * (1.f / DM) + EPS);
}
__device__ __forceinline__ float jq_max(float v) { v = fmaxf(v, swz16(v)); auto rr = __builtin_amdgcn_permlane32_swap(__float_as_uint(v), __float_as_uint(v), false, false); return fmaxf(__uint_as_float(rr[0]), __uint_as_float(rr[1])); }
__device__ __forceinline__ float jq_sum(float v) { v += swz16(v); auto rr = __builtin_amdgcn_permlane32_swap(__float_as_uint(v), __float_as_uint(v), false, false); return __uint_as_float(rr[0]) + __uint_as_float(rr[1]); }
template <int NHALF, bool KEEP_P>
__device__ __forceinline__ void seg3(const f32x4 (&qr)[4], const float* base, int count, int pos0, int pstep, int t, int lo_pos, const float (&slope)[4], int lane  ,
                                     float (&m)[4], float (&l)[4], f32x4 (&o)[4], float (&pk)[8][4]) {
    asm volatile("" : "+v"(lane));
    const int d4 = lane & 15, jq = lane >> 4;
#pragma unroll
    for (int hf = 0; hf < NHALF; ++hf) {
        f32x4 kv[1][8], vv[1][8];
#pragma unroll
        for (int i = 0; i < 8; ++i) { const int j = 4 * (8 * hf + i) + jq; const float* rp = base + (size_t)(j < count ? j : 0) * 256 + 4 * d4;
            kv[0][i] = __builtin_nontemporal_load((const f32x4*)rp); vv[0][i] = __builtin_nontemporal_load((const f32x4*)(rp + 128)); }
        __builtin_amdgcn_sched_barrier(0);
        float s[8][4];
#pragma unroll
        for (int i = 0; i < 8; ++i) { const int j = 4 * (8 * hf + i) + jq, pos = pos0 + j * pstep; const bool valid = (j < count) && (pos <= t) && (pos >= lo_pos); const float dist = (float)(t - pos);
#pragma unroll
            for (int h = 0; h < 4; ++h) { const f32x4 a = kv[0][i], q = qr[h]; float dd = (a.x * q.x + a.y * q.y) + (a.z * q.z + a.w * q.w);
                dd += dppf<0xB1>(dd); dd += dppf<0x4E>(dd); dd += dppf<0x141>(dd); dd += dppf<0x140>(dd);
                s[i][h] = valid ? dd - slope[h] * dist : -1e30f; } }
#pragma unroll
        for (int h = 0; h < 4; ++h) { float mx = s[0][h];
#pragma unroll
            for (int i = 1; i < 8; ++i) mx = fmaxf(mx, s[i][h]);
            mx = jq_max(mx);
            const float mn = fmaxf(m[h], mx), alpha = __builtin_amdgcn_exp2f(m[h] - mn); float ls = 0.f; f32x4 acc = o[h] * alpha;
#pragma unroll
            for (int i = 0; i < 8; ++i) { const float p = s[i][h] > -1e29f ? __builtin_amdgcn_exp2f(s[i][h] - mn) : 0.f; ls += p; acc = acc + vv[0][i] * p; if (KEEP_P && hf == 0) pk[i][h] = p; }
            l[h] = l[h] * alpha + ls; o[h] = acc; m[h] = mn; }
        __builtin_amdgcn_sched_barrier(0);
    }
}
__device__ __forceinline__ f32x4 red_jq(f32x4 v, int lane) {
    const int a = (lane ^ 16) << 2, b = (lane ^ 32) << 2;
    v.x += shx(v.x, a); v.y += shx(v.y, a); v.z += shx(v.z, a); v.w += shx(v.w, a);
    v.x += shx(v.x, b); v.y += shx(v.y, b); v.z += shx(v.z, b); v.w += shx(v.w, b);
    return v;
}
__device__ __forceinline__ void seg_one(const f32x4 (&qr)[4], const f32x4 kx, const f32x4 vx, const float (&slope)[4], float dist, int lane, float (&m)[4], float (&l)[4], f32x4 (&o)[4]) {
    asm volatile("" : "+v"(lane));
    const int jq = lane >> 4;
#pragma unroll
    for (int h = 0; h < 4; ++h) { const f32x4 q = qr[h]; float dd = (kx.x * q.x + kx.y * q.y) + (kx.z * q.z + kx.w * q.w);
        dd += dppf<0xB1>(dd); dd += dppf<0x4E>(dd); dd += dppf<0x141>(dd); dd += dppf<0x140>(dd);
        const float s = jq == 0 ? dd - slope[h] * dist : -1e30f;
        const float mx = jq_max(s), mn = fmaxf(m[h], mx), alpha = __builtin_amdgcn_exp2f(m[h] - mn);
        const float p = s > -1e29f ? __builtin_amdgcn_exp2f(s - mn) : 0.f;
        l[h] = l[h] * alpha + p; o[h] = o[h] * alpha + vx * p; m[h] = mn; }
}
struct AttnPtrs { const bf16* Q; const float* GT; const float* KCS; const float* ks_s; const float* KWF; const float* cache_sel; const float* cache_win; const int* page_table; const bf16* ZA; bf16* MIX; unsigned* cnt; };
__device__ __forceinline__ void sample_unit(const AttnPtrs& A, int l, int sb, int kvh, LAS float* L, int tid, int lane, int wave) {
    asm volatile("" : "+v"(tid), "+v"(lane));
    LAS float* qs = L; LAS float* pw = L + 256 + wave * 256; LAS float* OC = L + 256 + 2048; LAS float* ML = OC + 256; LAS float* OS = ML + 128; LAS float* OW = OS + 2048;
    const int row = MP + sb, t = PAST;
    if (tid < 64) { const v2u qq = *(const v2u*)(A.Q + (size_t)row * 512 + kvh * 256 + tid * 4);
        f32x4 qf; qf.x = bf2f((unsigned short)(qq.x & 0xffffu)); qf.y = bf2f((unsigned short)(qq.x >> 16)); qf.z = bf2f((unsigned short)(qq.y & 0xffffu)); qf.w = bf2f((unsigned short)(qq.y >> 16));
        *(LAS f32x4*)(qs + tid * 4) = qf; }
    int pagev = 0; if (lane < 32) pagev = A.page_table[sb * NPAGES + (lane >> 1)];
    LAS float* NK = OW + 2048;
    if (wave == 7) { const int which = lane >> 4, d = 4 * (lane & 15); const float* p1 = (which < 2 ? A.ks_s + (size_t)sb * 256 : A.KWF + (size_t)row * 256) + kvh * 64 + (which & 1) * 128 + d;
        *(LAS f32x4*)(NK + which * 64 + d) = *(const f32x4*)p1; }
    __syncthreads();
    float slope[4];
    float l2e = LOG2E; asm volatile("" : "+v"(l2e));
#pragma unroll
    for (int h = 0; h < 4; ++h) slope[h] = exp2f(-(float)(kvh * 4 + h + 1)) * l2e;
    const int d4 = lane & 15, jq = lane >> 4;
    f32x4 qr[4];
#pragma unroll
    for (int h = 0; h < 4; ++h) qr[h] = *(const LAS f32x4*)(qs + h * 64 + 4 * d4);
    float pdum[8][4];
    unsigned long long mask;
    { float mc[4], lc[4], pk[8][4], inv[4]; f32x4 oc[4];
#pragma unroll
      for (int h = 0; h < 4; ++h) { mc[h] = -1e30f; lc[h] = 0.f; oc[h] = (f32x4){0.f, 0.f, 0.f, 0.f}; }
      seg3<1, true>(qr, A.KCS + ((size_t)l * DECB + sb) * 32 * 256 + kvh * 64, 32, 63, 64, t, 0, slope, lane, mc, lc, oc, pk);
#pragma unroll
      for (int h = 0; h < 4; ++h) { const float lt = jq_sum(lc[h]); inv[h] = lt > 0.f ? 1.f / lt : 0.f; oc[h] = red_jq(oc[h], lane) * inv[h]; }
#pragma unroll
      for (int i = 0; i < 8; ++i) { const float v = (pk[i][0] * inv[0] + pk[i][1] * inv[1]) + (pk[i][2] * inv[2] + pk[i][3] * inv[3]); if (d4 == 0) pw[4 * i + jq] = v; }
      LDS_WAIT(); asm volatile("" ::: "memory");
      const float imp = lane < 32 ? pw[lane] : 0.f;
      LDS_WAIT(); asm volatile("" ::: "memory");
      if (wave == 0 && lane < 16) {
#pragma unroll
          for (int h = 0; h < 4; ++h) *(LAS f32x4*)(OC + h * 64 + 4 * d4) = oc[h]; }
      const int nblk = 33, cur = t >> 6;
      float score;
      if (lane >= nblk) score = -3e4f; else if (lane == 0 || lane == cur) score = 1e4f; else if (lane <= cur) score = imp; else score = -1e4f;
      int rank = 0;
      for (int j = 0; j < nblk; ++j) { const float sj = rdlane(score, j); rank += (sj > score || (sj == score && j < lane)) ? 1 : 0; }
      mask = __ballot(rank < 16 && score > -5000.f);
    }
    float ms[4], ls[4]; f32x4 os[4];
#pragma unroll
    for (int h = 0; h < 4; ++h) { ms[h] = -1e30f; ls[h] = 0.f; os[h] = (f32x4){0.f, 0.f, 0.f, 0.f}; }
    { int k = 0;
      while (mask) { const int j = __builtin_ctzll(mask); mask &= mask - 1;
          if ((k >> 1) == wave) {
              const float* base; int count = 64;
              if (j < 32) { const int page = __builtin_amdgcn_readlane(pagev, j); base = A.cache_sel + (((size_t)l * NPHYS + page) * PAGE + (j & 1) * 64) * 256 + kvh * 64;
                  seg3<2, false>(qr, base, count, 64 * j, 1, t, 0, slope, lane, ms, ls, os, pdum); }
              else seg_one(qr, *(const LAS f32x4*)(NK + 4 * d4), *(const LAS f32x4*)(NK + 64 + 4 * d4), slope, (float)(t - 64 * j), lane, ms, ls, os); }
          ++k; } }
    float mw[4], lw[4]; f32x4 ow[4];
#pragma unroll
    for (int h = 0; h < 4; ++h) { mw[h] = -1e30f; lw[h] = 0.f; ow[h] = (f32x4){0.f, 0.f, 0.f, 0.f}; }
    { const int lo = PAST - (WINDOW - 1), p0 = lo + 64 * wave, count = (PAST - p0) < 64 ? (PAST - p0) : 64;
      seg3<2, false>(qr, A.cache_win + (((size_t)l * DECB + sb) * 512 + (p0 - (PAST - 512))) * 256 + kvh * 64, count, p0, 1, t, lo, slope, lane, mw, lw, ow, pdum);
      if (wave == 7) seg_one(qr, *(const LAS f32x4*)(NK + 128 + 4 * d4), *(const LAS f32x4*)(NK + 192 + 4 * d4), slope, (float)(t - PAST), lane, mw, lw, ow); }
#pragma unroll
    for (int h = 0; h < 4; ++h) { os[h] = red_jq(os[h], lane); ow[h] = red_jq(ow[h], lane); ls[h] = jq_sum(ls[h]); lw[h] = jq_sum(lw[h]); }
    if (lane < 16) {
#pragma unroll
        for (int h = 0; h < 4; ++h) { *(LAS f32x4*)(OS + wave * 256 + h * 64 + 4 * d4) = os[h]; *(LAS f32x4*)(OW + wave * 256 + h * 64 + 4 * d4) = ow[h]; } }
    if (lane == 0) {
#pragma unroll
        for (int h = 0; h < 4; ++h) { ML[wave * 16 + h] = ms[h]; ML[wave * 16 + 4 + h] = ls[h]; ML[wave * 16 + 8 + h] = mw[h]; ML[wave * 16 + 12 + h] = lw[h]; } }
    __syncthreads();
    if (tid < 256) { const int h = tid >> 6, dd = tid & 63;
        const float* g = A.GT + (size_t)row * 32 + (kvh * 4 + h) * 3; const size_t idx = (size_t)row * 512 + kvh * 256 + h * 64 + dd;
        const float g0 = g[0], g1 = g[1], g2 = g[2], zav = bf2f(A.ZA[idx]);
        float Ms = -1e30f, Mw = -1e30f;
#pragma unroll
        for (int w = 0; w < 8; ++w) { Ms = fmaxf(Ms, ML[w * 16 + h]); Mw = fmaxf(Mw, ML[w * 16 + 8 + h]); }
        float Ls = 0.f, Lw = 0.f, Os = 0.f, Ow = 0.f;
#pragma unroll
        for (int w = 0; w < 8; ++w) { const float fs = exp2f(ML[w * 16 + h] - Ms), fw = exp2f(ML[w * 16 + 8 + h] - Mw);
            Ls += ML[w * 16 + 4 + h] * fs; Lw += ML[w * 16 + 12 + h] * fw; Os += OS[w * 256 + h * 64 + dd] * fs; Ow += OW[w * 256 + h * 64 + dd] * fw; }
        const float ya = g0 * OC[h * 64 + dd] + g1 * Os / fmaxf(Ls, 1e-30f) + g2 * Ow / fmaxf(Lw, 1e-30f);
        qs[tid] = ya * zav; }
    __syncthreads();
    if (tid < 64) { const f32x4 y = *(const LAS f32x4*)(qs + 4 * tid);
        const unsigned long long w = (unsigned long long)pk2(y.x, y.y) | ((unsigned long long)pk2(y.z, y.w) << 32);
        __hip_atomic_store((unsigned long long*)(A.MIX + (size_t)row * 1024 + kvh * 256 + 4 * tid), w, __ATOMIC_RELAXED, __HIP_MEMORY_SCOPE_AGENT); }
    asm volatile("s_waitcnt vmcnt(0)" ::: "memory");
    __syncthreads();
    if (tid == 0) __hip_atomic_fetch_add(A.cnt, 1u, __ATOMIC_RELAXED, __HIP_MEMORY_SCOPE_AGENT);
}


#ifndef REP_CMP
#define REP_CMP 1
#endif
#ifndef REP_SEL
#define REP_SEL 1
#endif
#ifndef REP_WIN
#define REP_WIN 1
#endif
namespace att {
typedef short bf16x8 __attribute__((ext_vector_type(8)));
typedef short s16x4 __attribute__((ext_vector_type(4)));
typedef short v4i16_t __attribute__((ext_vector_type(4)));
typedef float f32x16 __attribute__((ext_vector_type(16)));
typedef __bf16 bf16x2_t __attribute__((ext_vector_type(2)));
typedef float f32x2_t __attribute__((ext_vector_type(2)));
typedef LAS const char* lds_cptr;
constexpr int KVB = 16384;
constexpr int OFF_WS = 2 * KVB, WS_STRIDE = 8704 + 2048;
constexpr int OFF_MASK = OFF_WS + 8 * WS_STRIDE;
constexpr int ATT_LDS = OFF_MASK + 512;
constexpr float NEG = -2e30f, MINIT = -1e30f;
#define ADI __device__ __forceinline__
ADI unsigned cvtpk(float lo, float hi) { f32x2_t v = {lo, hi}; bf16x2_t b = __builtin_convertvector(v, bf16x2_t); return __builtin_bit_cast(unsigned, b); }
ADI f32x16 mfma32(bf16x8 a, bf16x8 b, f32x16 c) { return __builtin_amdgcn_mfma_f32_32x32x16_bf16(a, b, c, 0, 0, 0); }
ADI s16x4 vtr(lds_cptr p) { return __builtin_bit_cast(s16x4, __builtin_amdgcn_ds_read_tr16_b64_v4i16((LAS v4i16_t*)p)); }
ADI float xhalf_max(float m) { auto rr = __builtin_amdgcn_permlane32_swap(__float_as_uint(m), __float_as_uint(m), false, false); return fmaxf(__uint_as_float(rr[0]), __uint_as_float(rr[1])); }
ADI float xhalf_sum(float m) { auto rr = __builtin_amdgcn_permlane32_swap(__float_as_uint(m), __float_as_uint(m), false, false); return __uint_as_float(rr[0]) + __uint_as_float(rr[1]); }
template <int CTRL> ADI float qperm(float v) { return __builtin_bit_cast(float, __builtin_amdgcn_update_dpp(0, __builtin_bit_cast(int, v), CTRL, 0xF, 0xF, true)); }
ADI bf16x8 pack8(const f32x16& x, int s) { v4u p; p.x = cvtpk(x[8 * s], x[8 * s + 1]); p.y = cvtpk(x[8 * s + 2], x[8 * s + 3]); p.z = cvtpk(x[8 * s + 4], x[8 * s + 5]); p.w = cvtpk(x[8 * s + 6], x[8 * s + 7]); return __builtin_bit_cast(bf16x8, p); }
constexpr int crow_c(int i) { return (i & 3) + 8 * (i >> 2); }

ADI void stage_store(LAS char* buf, int tid, v4u kr, v4u vr) {
    const int row = tid >> 3, ch = tid & 7;
    *(LAS v4u*)(buf + row * 128 + 16 * (ch ^ ((row >> 1) & 7))) = kr;
    *(LAS v4u*)(buf + 8192 + row * 128 + 16 * (ch ^ (4 * ((row >> 1) & 1)))) = vr;
}
ADI void k_load(bf16x8 (&kf)[2][4], lds_cptr kb, int r, int h) {
    const int sw = (r >> 1) & 7;
#pragma unroll
    for (int kbk = 0; kbk < 2; ++kbk)
#pragma unroll
        for (int s = 0; s < 4; ++s) kf[kbk][s] = *(const LAS bf16x8*)(kb + (32 * kbk + r) * 128 + 16 * ((2 * s + h) ^ sw));
}
ADI void qk_mma(f32x16 (&S)[2], const bf16x8 (&kf)[2][4], const bf16x8 (&qf)[4]) {
#pragma unroll
    for (int s = 0; s < 4; ++s)
#pragma unroll
        for (int kbk = 0; kbk < 2; ++kbk) S[kbk] = mfma32(kf[kbk][s], qf[s], S[kbk]);
}
ADI void v_load(bf16x8 (&vf)[2][2], lds_cptr vb, int kbk, int lane) {
    const int i16 = lane & 15, q = i16 >> 2, p = i16 & 3, blk = (lane >> 4) & 1, h = lane >> 5, sq = (q >> 1) & 1;
    lds_cptr base = vb + (4 * h + q) * 128 + 16 * (2 * blk + (p >> 1)) + 8 * (p & 1);
#pragma unroll
    for (int s = 0; s < 2; ++s)
#pragma unroll
        for (int db = 0; db < 2; ++db) {
            lds_cptr a = base + (32 * kbk + 16 * s) * 128 + 64 * (db ^ sq);
            const s16x4 lo = vtr(a), hi = vtr(a + 8 * 128);
            vf[s][db] = (bf16x8){lo[0], lo[1], lo[2], lo[3], hi[0], hi[1], hi[2], hi[3]};
        }
}
ADI void pv_mma(f32x16 (&O)[2], const bf16x8 (&vf)[2][2], const f32x16& P) {
#pragma unroll
    for (int s = 0; s < 2; ++s) {
        const bf16x8 pf = pack8(P, s);
#pragma unroll
        for (int db = 0; db < 2; ++db) O[db] = mfma32(vf[s][db], pf, O[db]);
    }
}
ADI void softmax_tile(f32x16 (&S)[2], f32x16 (&O)[2], float& m, float& l) {
    float mx = S[0][0];
#pragma unroll
    for (int i = 1; i < 16; ++i) mx = fmaxf(mx, S[0][i]);
#pragma unroll
    for (int i = 0; i < 16; ++i) mx = fmaxf(mx, S[1][i]);
    mx = xhalf_max(mx);
    const float mn = fmaxf(m, mx), alpha = __builtin_amdgcn_exp2f(m - mn);
    float sum = 0.f;
#pragma unroll
    for (int kbk = 0; kbk < 2; ++kbk)
#pragma unroll
        for (int i = 0; i < 16; ++i) { const float pv = __builtin_amdgcn_exp2f(S[kbk][i] - mn); S[kbk][i] = pv; sum += pv; }
    l = l * alpha + sum;
    if (__any(mn > m)) {
#pragma unroll
        for (int db = 0; db < 2; ++db)
#pragma unroll
            for (int i = 0; i < 16; ++i) O[db][i] *= alpha;
    }
    m = mn;
}
ADI void init_bias(f32x16 (&S)[2], float c0, float slope) {
#pragma unroll
    for (int kbk = 0; kbk < 2; ++kbk)
#pragma unroll
        for (int i = 0; i < 16; ++i) S[kbk][i] = fmaf(slope, (float)(32 * kbk + crow_c(i)), c0);
}
template <int MODE> ADI void mask_tile(f32x16 (&S)[2], int lim, int h) {
#pragma unroll
    for (int kbk = 0; kbk < 2; ++kbk)
#pragma unroll
        for (int i = 0; i < 16; ++i) { const int koff = 32 * kbk + crow_c(i) + 4 * h; const bool keep = (MODE == 1) ? (koff <= lim) : (koff > lim); S[kbk][i] = keep ? S[kbk][i] : NEG; }
}

struct Side { const float* src; float* dst; int c, cend, G, bx, pend; };
constexpr unsigned SIDE_N4 = 2u * 128u * 511u * 64u;
constexpr int OFF_SIDE = ATT_LDS, OFF_SIDE1 = 135168;
static_assert(OFF_SIDE + 8192 <= RING_BYTES && OFF_SIDE1 >= MISC_OFF + 1024 && OFF_SIDE1 + 8192 <= LDS_BYTES, "side-stream staging");
ADI unsigned side_idx(const Side& sd, int c, int tid) { return ((unsigned)c * (unsigned)sd.G + (unsigned)sd.bx) * 512u + (unsigned)tid; }
ADI void side_load(const Side& sd, int tid, int w, LAS char* lds) { const unsigned i = side_idx(sd, sd.c, tid); if (i < SIDE_N4) { const unsigned lb = i / 32704u, r = i - lb * 32704u;
    const float* p = sd.src + (size_t)lb * 131072 + 256 + (size_t)r * 4; const unsigned la = (unsigned)(size_t)(lds + ((sd.c & 1) ? OFF_SIDE1 : OFF_SIDE)) + (unsigned)w * 1024u;
    asm volatile("s_mov_b32 m0, %1\n\ts_nop 0\n\tglobal_load_lds_dwordx4 %0, off nt" :: "v"(p), "s"(la) : "memory", "m0"); } }
ADI void side_step(Side& sd, int tid, int w, LAS char* lds) {
    if (sd.pend) { const int c = sd.c - 1; const unsigned i = side_idx(sd, c, tid);
        asm volatile("s_waitcnt vmcnt(0)" ::: "memory");
        if (i < SIDE_N4) { const unsigned lb = i / 32704u, r = i - lb * 32704u; const f32x4 v = *(const LAS f32x4*)(lds + ((c & 1) ? OFF_SIDE1 : OFF_SIDE) + tid * 16); __builtin_nontemporal_store(v, (f32x4*)(sd.dst + (size_t)lb * 131072 + (size_t)r * 4)); }
        asm volatile("s_waitcnt lgkmcnt(0)" ::: "memory"); }
    const bool ld = sd.c < sd.cend; if (ld) side_load(sd, tid, w, lds);
    sd.pend = ld ? 1 : 0; if (ld) ++sd.c; }
struct Ptrs { const bf16* Q; const float* GT; const float* KCP; const bf16* KSB; const bf16* KWB; const bf16* ZA; bf16* MIX; };

ADI void unit(const Ptrs& A, int b, int kvh, int qb, LAS char* lds, int tid, int lane, int w, Side& sd) {
    asm volatile("" : "+v"(tid), "+v"(lane));
    const int r = lane & 31, h = lane >> 5, tl = r >> 2, g = r & 3, tokl = 8 * w + tl, t = 64 * qb + tokl, head = kvh * 4 + g;
    const size_t row = (size_t)b * SEQ + t;
    const float slope = __builtin_amdgcn_exp2f(-(float)(head + 1)) * LOG2E;
    bf16x8 qf[4];
#pragma unroll
    for (int s = 0; s < 4; ++s) qf[s] = *(const bf16x8*)(A.Q + row * 512 + head * 64 + 16 * s + 8 * h);
    const float g0 = A.GT[row * 32 + head * 3], g1 = A.GT[row * 32 + head * 3 + 1], g2 = A.GT[row * 32 + head * 3 + 2];
    LAS char* buf0 = lds; LAS char* buf1 = lds + KVB;
    { const int prow = tid >> 3, pc = tid & 7, chK = pc ^ ((prow >> 1) & 7), chV = pc ^ (4 * ((prow >> 1) & 1));
      const bf16* pk_ = A.KSB + ((size_t)b * SEQ + 64 * qb + prow) * 256 + kvh * 64; const bf16* sk_ = pk_ + chK * 8; const bf16* sv_ = pk_ + 128 + chV * 8;
      const unsigned la = (unsigned)(size_t)buf1 + (unsigned)w * 1024u;
      asm volatile("s_mov_b32 m0, %1\n\ts_nop 0\n\tglobal_load_lds_dwordx4 %0, off" :: "v"(sk_), "s"(la) : "memory", "m0");
      asm volatile("s_mov_b32 m0, %1\n\ts_nop 0\n\tglobal_load_lds_dwordx4 %0, off" :: "v"(sv_), "s"(la + 8192u) : "memory", "m0"); }
    LAS float* wsf = (LAS float*)(lds + OFF_WS + w * WS_STRIDE);
    LAS unsigned long long* masks = (LAS unsigned long long*)(lds + OFF_MASK);
    const int srow = tid >> 3, sch = tid & 7;
    LAS float* impf = wsf + 32 * 68;
    LAS float* yaf = wsf + r * 68 + 4 * h;
    for (int rep = 0; rep < REP_CMP; ++rep) {
        if (rep) __syncthreads();
        const float* kc = A.KCP + (((size_t)b * 64 + srow) * 4 + kvh) * 64 + sch * 8;
        const f32x4 k0 = *(const f32x4*)kc, k1 = *(const f32x4*)(kc + 4), v0 = *(const f32x4*)(kc + 128), v1 = *(const f32x4*)(kc + 132);
        v4u kr, vr; kr.x = cvtpk(k0.x, k0.y); kr.y = cvtpk(k0.z, k0.w); kr.z = cvtpk(k1.x, k1.y); kr.w = cvtpk(k1.z, k1.w);
        vr.x = cvtpk(v0.x, v0.y); vr.y = cvtpk(v0.z, v0.w); vr.z = cvtpk(v1.x, v1.y); vr.w = cvtpk(v1.z, v1.w);
        stage_store(buf0, tid, kr, vr);
        __syncthreads();
        f32x16 S[2], O[2];
        bf16x8 kf[2][4], vf0[2][2], vf1[2][2];
        k_load(kf, buf0, r, h);
        init_bias(S, slope * (float)(63 + 256 * h - t), slope * 64.f);
        qk_mma(S, kf, qf);
        v_load(vf0, buf0 + 8192, 0, lane);
        __builtin_amdgcn_sched_barrier(0);
        const int ncv = qb + (tokl == 63 ? 1 : 0);
        mask_tile<1>(S, ncv - 1, h);
#pragma unroll
        for (int db = 0; db < 2; ++db)
#pragma unroll
            for (int i = 0; i < 16; ++i) O[db][i] = 0.f;
        float m = MINIT, l = 0.f;
        softmax_tile(S, O, m, l);
        l = xhalf_sum(l);
        const float inv = l > 0.f ? 1.f / l : 0.f;
#pragma unroll
        for (int kbk = 0; kbk < 2; ++kbk)
#pragma unroll
            for (int i = 0; i < 16; ++i) S[kbk][i] *= inv;
#pragma unroll
        for (int kbk = 0; kbk < 2; ++kbk)
#pragma unroll
            for (int i = 0; i < 16; ++i) { float v = S[kbk][i]; v += qperm<0xB1>(v); v += qperm<0x4E>(v); if (g == 0) impf[tl * 64 + 32 * kbk + crow_c(i) + 4 * h] = v; }
        v_load(vf1, buf0 + 8192, 1, lane);
        pv_mma(O, vf0, S[0]);
        pv_mma(O, vf1, S[1]);
#pragma unroll
        for (int db = 0; db < 2; ++db)
#pragma unroll
            for (int gq = 0; gq < 4; ++gq) { const f32x4 v = {g0 * O[db][4 * gq], g0 * O[db][4 * gq + 1], g0 * O[db][4 * gq + 2], g0 * O[db][4 * gq + 3]}; *(LAS f32x4*)(yaf + 32 * db + 8 * gq) = v; }
    }
    LDS_WAIT(); asm volatile("" ::: "memory");
    if (qb < 16) { if (lane < 8) masks[8 * w + lane] = (2ull << qb) - 1ull; }
    else {
        const bool near = lane >= qb - 14 && lane < qb, far = lane >= 1 && lane < qb - 14;
        float vv[8], a_[8], b_[8];
#pragma unroll
        for (int k = 0; k < 8; ++k) { vv[k] = impf[k * 64 + lane]; a_[k] = near ? -vv[k] : -3e38f; b_[k] = far ? vv[k] : -3e38f; }
#pragma unroll
        for (int k = 0; k < 8; ++k) { a_[k] = wave_max(a_[k]); b_[k] = wave_max(b_[k]); }
#pragma unroll 1
        for (int k = 0; k < 8; ++k) {
            unsigned long long mk;
            float mn = 0.f, mf = 0.f;
#pragma unroll
            for (int q = 0; q < 8; ++q) if (q == k) { mn = -a_[q]; mf = b_[q]; }
            if (mn > mf) mk = (((1ull << 15) - 1ull) << (qb - 14)) | 1ull;
            else {
                float v = 0.f;
#pragma unroll
                for (int q = 0; q < 8; ++q) if (q == k) v = vv[q];
                const float score = (lane == 0 || lane == qb) ? 1e4f : (lane < qb ? v : -1e4f);
                int rank = 0;
                for (int j = 0; j <= qb; ++j) { const float sj = rdlane(score, j); rank += (sj > score || (sj == score && j < lane)) ? 1 : 0; }
                mk = __ballot(rank < 16 && lane <= qb); }
            if (lane == 0) masks[8 * w + k] = mk;
        }
    }
    __syncthreads();
    const unsigned long long mymask = masks[tokl];
    unsigned long long un = masks[lane];
#pragma unroll
    for (int o = 1; o < 64; o <<= 1) { const unsigned lo = shxu((unsigned)un, (lane ^ o) << 2), hi = shxu((unsigned)(un >> 32), (lane ^ o) << 2); un |= ((unsigned long long)hi << 32) | lo; }
    un = ((unsigned long long)(unsigned)__builtin_amdgcn_readfirstlane((unsigned)(un >> 32)) << 32) | (unsigned long long)(unsigned)__builtin_amdgcn_readfirstlane((unsigned)un);
    const unsigned long long un_all = un;
    int curw = 0;
    for (int rep = 0; rep < REP_SEL; ++rep) {
        if (rep) __syncthreads();
        un = un_all;
        f32x16 O[2];
#pragma unroll
        for (int db = 0; db < 2; ++db)
#pragma unroll
            for (int i = 0; i < 16; ++i) O[db][i] = 0.f;
        float m = MINIT, l = 0.f;
        const bf16* kbase = A.KSB + ((size_t)b * SEQ + srow) * 256 + kvh * 64 + sch * 8;
        int j = 63 - __builtin_clzll(un); un &= ~(1ull << j);
        if (rep) { const bf16* p = kbase + (size_t)j * 64 * 256; stage_store(buf1, tid, *(const v4u*)p, *(const v4u*)(p + 128)); }
        asm volatile("s_waitcnt vmcnt(0)" ::: "memory");
        __syncthreads();
        int cur = 1;
        for (;;) {
            const bool more = un != 0ull; int jn = 0; v4u kr, vr;
            side_step(sd, tid, w, lds);
            if (more) { jn = 63 - __builtin_clzll(un); un &= ~(1ull << jn); const bf16* p = kbase + (size_t)jn * 64 * 256; kr = *(const v4u*)p; vr = *(const v4u*)(p + 128); }
            else { const bf16* p = A.KWB + ((size_t)b * SEQ + srow + 64 * qb) * 256 + kvh * 64 + sch * 8; kr = *(const v4u*)p; vr = *(const v4u*)(p + 128); }
            LAS char* bc = cur ? buf1 : buf0;
            f32x16 S[2];
            const bool sel = (mymask >> j) & 1ull;
            bf16x8 kf[2][4], vf0[2][2], vf1[2][2];
            k_load(kf, bc, r, h);
            init_bias(S, sel ? slope * (float)(64 * j + 4 * h - t) : NEG, slope);
            qk_mma(S, kf, qf);
            v_load(vf0, bc + 8192, 0, lane);
            if (j == qb) mask_tile<1>(S, tokl, h);
            softmax_tile(S, O, m, l);
            v_load(vf1, bc + 8192, 1, lane);
        pv_mma(O, vf0, S[0]);
        pv_mma(O, vf1, S[1]);
            stage_store(cur ? buf0 : buf1, tid, kr, vr);
            __syncthreads();
            cur ^= 1; j = jn;
            if (!more) break;
        }
        curw = cur;
        l = xhalf_sum(l);
        const float sc = g1 / fmaxf(l, 1e-30f);
        if (rep == REP_SEL - 1)
#pragma unroll
        for (int db = 0; db < 2; ++db)
#pragma unroll
            for (int gq = 0; gq < 4; ++gq) { f32x4 v = *(const LAS f32x4*)(yaf + 32 * db + 8 * gq);
                v.x += sc * O[db][4 * gq]; v.y += sc * O[db][4 * gq + 1]; v.z += sc * O[db][4 * gq + 2]; v.w += sc * O[db][4 * gq + 3]; *(LAS f32x4*)(yaf + 32 * db + 8 * gq) = v; }
    }
    __syncthreads();
    for (int rep = 0; rep < REP_WIN; ++rep) {
        if (rep) __syncthreads();
        f32x16 O[2];
#pragma unroll
        for (int db = 0; db < 2; ++db)
#pragma unroll
            for (int i = 0; i < 16; ++i) O[db][i] = 0.f;
        float m = MINIT, l = 0.f;
        const bf16* kbase = A.KWB + ((size_t)b * SEQ + srow) * 256 + kvh * 64 + sch * 8;
        const int jlo = qb - 8 > 0 ? qb - 8 : 0; int j = qb;
        if (rep) { const bf16* p = kbase + (size_t)j * 64 * 256; stage_store(curw ? buf1 : buf0, tid, *(const v4u*)p, *(const v4u*)(p + 128)); __syncthreads(); }
        int cur = curw;
        for (;;) {
            const bool more = j > jlo; v4u kr, vr;
            side_step(sd, tid, w, lds);
            if (more) { const bf16* p = kbase + (size_t)(j - 1) * 64 * 256; kr = *(const v4u*)p; vr = *(const v4u*)(p + 128); }
            LAS char* bc = cur ? buf1 : buf0;
            f32x16 S[2];
            bf16x8 kf[2][4], vf0[2][2], vf1[2][2];
            k_load(kf, bc, r, h);
            init_bias(S, slope * (float)(64 * j + 4 * h - t), slope);
            qk_mma(S, kf, qf);
            v_load(vf0, bc + 8192, 0, lane);
            if (j == qb) mask_tile<1>(S, tokl, h);
            if (j == qb - 8) mask_tile<2>(S, tokl, h);
            softmax_tile(S, O, m, l);
            v_load(vf1, bc + 8192, 1, lane);
        pv_mma(O, vf0, S[0]);
        pv_mma(O, vf1, S[1]);
            if (!more) break;
            stage_store(cur ? buf0 : buf1, tid, kr, vr);
            __syncthreads();
            cur ^= 1; --j;
        }
        l = xhalf_sum(l);
        const float sc = g2 / fmaxf(l, 1e-30f);
        if (rep == REP_WIN - 1)
#pragma unroll
        for (int db = 0; db < 2; ++db)
#pragma unroll
            for (int gq = 0; gq < 4; ++gq) { f32x4 v = *(const LAS f32x4*)(yaf + 32 * db + 8 * gq);
                v.x += sc * O[db][4 * gq]; v.y += sc * O[db][4 * gq + 1]; v.z += sc * O[db][4 * gq + 2]; v.w += sc * O[db][4 * gq + 3]; *(LAS f32x4*)(yaf + 32 * db + 8 * gq) = v; }
    }
    v2u zg[8];
#pragma unroll
    for (int k = 0; k < 8; ++k) zg[k] = *(const v2u*)(A.ZA + ((size_t)b * SEQ + 64 * qb + 8 * w + k) * 512 + kvh * 256 + 4 * lane);
    LDS_WAIT(); asm volatile("" ::: "memory");
#pragma unroll
    for (int k = 0; k < 8; ++k) {
        const f32x4 y = *(const LAS f32x4*)(wsf + (4 * k + (lane >> 4)) * 68 + 4 * (lane & 15));
        const size_t orow = (size_t)b * SEQ + 64 * qb + 8 * w + k;
        const v2u z = zg[k];
        v2u o; o.x = cvtpk(y.x * bf2f((unsigned short)(z.x & 0xffffu)), y.y * bf2f((unsigned short)(z.x >> 16))); o.y = cvtpk(y.z * bf2f((unsigned short)(z.y & 0xffffu)), y.w * bf2f((unsigned short)(z.y >> 16)));
        *(v2u*)(A.MIX + orow * 1024 + kvh * 256 + 4 * lane) = o;
    }
    __syncthreads();
}
#undef ADI
}

namespace cmpk {
typedef short bf16x8 __attribute__((ext_vector_type(8)));
typedef float f32x16 __attribute__((ext_vector_type(16)));
typedef __bf16 bf16x2_t __attribute__((ext_vector_type(2)));
typedef float f32x2_t __attribute__((ext_vector_type(2)));
constexpr int OFF_W1T = 0, OFF_W2 = 16384, OFF_PART = OFF_W2 + 32768, OFF_X = OFF_PART + 2048, XBYTES = 32768, CMP_LDS = OFF_X + 2 * XBYTES;
#define CDI __device__ __forceinline__
CDI unsigned cvtpk(float lo, float hi) { f32x2_t v = {lo, hi}; bf16x2_t b = __builtin_convertvector(v, bf16x2_t); return __builtin_bit_cast(unsigned, b); }
CDI float xhalf_sum(float m) { auto rr = __builtin_amdgcn_permlane32_swap(__float_as_uint(m), __float_as_uint(m), false, false); return __uint_as_float(rr[0]) + __uint_as_float(rr[1]); }
CDI void stage_weights(const float* w1, const float* pe, LAS char* lds, int tid) {
    for (int q = tid; q < 1024; q += 512) { const int c = q & 7, e = (q >> 3) & 63, r = q >> 9; const float* s = w1 + ((size_t)r * 64 + 8 * c) * 64 + e;
        v4u o; o.x = cvtpk(s[0], s[64]); o.y = cvtpk(s[128], s[192]); o.z = cvtpk(s[256], s[320]); o.w = cvtpk(s[384], s[448]);
        *(LAS v4u*)(lds + OFF_W1T + (r * 64 + e) * 128 + 16 * (c ^ ((e >> 1) & 7))) = o; }
    for (int q = tid; q < 2048; q += 512) *(LAS f32x4*)(lds + OFF_W2 + q * 16) = *(const f32x4*)(pe + q * 4);
}
CDI void load_rows(const float* src, int tid, f32x4 (&v)[8]) {
#pragma unroll
    for (int k = 0; k < 8; ++k) v[k] = __builtin_nontemporal_load((const f32x4*)(src + (size_t)(tid + 512 * k) * 4));
}
CDI void store_rows(LAS char* xb, const LAS char* pe, int tid, const f32x4 (&v)[8]) {
    f32x4 p[8];
#pragma unroll
    for (int k = 0; k < 8; ++k) { const int q = tid + 512 * k, c = q >> 6, col = (q & 63) * 4, r = col >> 7, dd = col & 63; p[k] = *(const LAS f32x4*)(pe + ((r * 64 + c) * 64 + dd) * 4); }
    __builtin_amdgcn_sched_barrier(0);
#pragma unroll
    for (int k = 0; k < 8; ++k) { const int q = tid + 512 * k, c = q >> 6, col4 = q & 63;
        const f32x4 x = v[k] + p[k];
        v2u o; o.x = cvtpk(x.x, x.y); o.y = cvtpk(x.z, x.w);
        *(LAS v2u*)(xb + c * 512 + 16 * ((col4 >> 1) ^ (c & 15)) + 8 * (col4 & 1)) = o; }
}
template <class Job, bool WT = false> CDI void run(const Job& J, int n, const float* pe, const float* w1, const float* w2, LAS char* lds, int tid, int lane, int wave) {
    if (n <= 0) return;
    f32x4 va[8], vb[8];
    load_rows(J.src(0), tid, va);
    if (!WT || n > 1) load_rows(J.src(n > 1 ? 1 : 0), tid, vb);
    const int rkF = wave >> 1, e2F = 32 * (wave & 1) + (lane & 31), ehF = lane >> 5;
    float w2r[32];
#pragma unroll
    for (int i = 0; i < 32; ++i) w2r[i] = w2[(size_t)(rkF >> 1) * 4096 + (32 * ehF + i) * 64 + e2F];
    stage_weights(w1, pe, lds, tid);
    __syncthreads();
    store_rows(lds + OFF_X, lds + OFF_W2, tid, va);
    __syncthreads();
    const int rk = wave & 3, th = wave >> 2, r = rk >> 1, r32 = lane & 31, h = lane >> 5;
    LAS float* part = (LAS float*)(lds + OFF_PART);
    bf16x8 bfr[2][4];
#pragma unroll
    for (int s = 0; s < 4; ++s)
#pragma unroll
        for (int eb = 0; eb < 2; ++eb) { const int e = 32 * eb + r32; bfr[eb][s] = *(const LAS bf16x8*)(lds + OFF_W1T + (r * 64 + e) * 128 + 16 * ((2 * s + h) ^ ((e >> 1) & 7))); }
    auto body = [&](int i) {
        const LAS char* X = lds + OFF_X + (i & 1) * XBYTES;
        f32x16 acc[2];
#pragma unroll
        for (int eb = 0; eb < 2; ++eb)
#pragma unroll
            for (int k = 0; k < 16; ++k) acc[eb][k] = 0.f;
        const int tok = 32 * th + r32;
        bf16x8 af[4];
#pragma unroll
        for (int s = 0; s < 4; ++s) af[s] = *(const LAS bf16x8*)(X + tok * 512 + 16 * ((8 * rk + 2 * s + h) ^ (tok & 15)));
        __builtin_amdgcn_sched_barrier(0);
#pragma unroll
        for (int s = 0; s < 4; ++s)
#pragma unroll
            for (int eb = 0; eb < 2; ++eb) acc[eb] = __builtin_amdgcn_mfma_f32_32x32x16_bf16(af[s], bfr[eb][s], acc[eb], 0, 0, 0);
#pragma unroll
        for (int eb = 0; eb < 2; ++eb) {
            f32x2_t s2 = {0.f, 0.f};
#pragma unroll
            for (int k = 0; k < 16; k += 2) { const f32x2_t x = {acc[eb][k], acc[eb][k + 1]}; f32x2_t t = x * -1.4426950408889634f;
                t.x = __builtin_amdgcn_exp2f(t.x); t.y = __builtin_amdgcn_exp2f(t.y); t = t + 1.f; t.x = __builtin_amdgcn_rcpf(t.x); t.y = __builtin_amdgcn_rcpf(t.y); s2 = s2 + x * t; }
            float sum = s2.x + s2.y;
            sum = xhalf_sum(sum);
            if (h == 0) part[wave * 64 + 32 * eb + r32] = sum; }
        __syncthreads();
        { float o = 0.f;
          const LAS f32x4* pa = (const LAS f32x4*)(part + rkF * 64 + 32 * ehF); const LAS f32x4* pb = (const LAS f32x4*)(part + (rkF + 4) * 64 + 32 * ehF);
          f32x4 qa[8], qb[8];
#pragma unroll
          for (int q = 0; q < 8; ++q) { qa[q] = pa[q]; qb[q] = pb[q]; }
          __builtin_amdgcn_sched_barrier(0);
#pragma unroll
          for (int q = 0; q < 8; ++q) { const f32x4 a = qa[q] + qb[q]; o += (a.x * w2r[4 * q] + a.y * w2r[4 * q + 1]) + (a.z * w2r[4 * q + 2] + a.w * w2r[4 * q + 3]); }
          o = xhalf_sum(o) * (1.f / 64.f);
          if (ehF == 0) {
              if (WT) __hip_atomic_store(J.dst(i) + rkF * 64 + e2F, o, __ATOMIC_RELAXED, __HIP_MEMORY_SCOPE_AGENT);
              else J.dst(i)[rkF * 64 + e2F] = o; } }
    };
#pragma nounroll
    for (int i = 0; i < n; i += 2) {
        if (!WT || i + 2 < n) load_rows(J.src(i + 2 < n ? i + 2 : n - 1), tid, va);
        body(i);
        if (i + 1 >= n) break;
        store_rows(lds + OFF_X + XBYTES, lds + OFF_W2, tid, vb);
        __syncthreads();
        if (!WT || i + 3 < n) load_rows(J.src(i + 3 < n ? i + 3 : n - 1), tid, vb);
        body(i + 1);
        if (i + 2 >= n) break;
        store_rows(lds + OFF_X, lds + OFF_W2, tid, va);
        __syncthreads();
    }
    asm volatile("s_waitcnt vmcnt(0)" ::: "memory");
    __syncthreads();
}
#undef CDI
}

namespace gm {
typedef short bf16x8 __attribute__((ext_vector_type(8)));
typedef short s16x4 __attribute__((ext_vector_type(4)));
typedef short v4i16_t __attribute__((ext_vector_type(4)));
typedef float f32x16 __attribute__((ext_vector_type(16)));
#define GDI __device__ __forceinline__
GDI s16x4 vtr(const LAS char* p) { return __builtin_bit_cast(s16x4, __builtin_amdgcn_ds_read_tr16_b64_v4i16((LAS v4i16_t*)p)); }
constexpr int crow_c(int i) { return (i & 3) + 8 * (i >> 2); }
GDI void unit(const float* V, const float* U, const bf16* ZC, bf16* MIX, const float* gn, const bf16* WGB, const float* gbs, float* gv_out, int row0, int gp, LAS char* lds, int tid, int lane, int wave) {
    const float gn0 = gn[(2 * gp) * 64 + lane], gn1 = gn[(2 * gp + 1) * 64 + lane];
    for (int it0 = 0; it0 < 32; it0 += 16) {
        float v[16];
#pragma unroll
        for (int k = 0; k < 16; ++k) { const int it = wave * 32 + it0 + k, i = it >> 1, g = 2 * gp + (it & 1); v[k] = V[(size_t)(row0 + i) * 256 + g * 64 + lane]; }
#pragma unroll
        for (int k = 0; k < 16; ++k) { const int it = wave * 32 + it0 + k, i = it >> 1, g = 2 * gp + (it & 1), ch = g * 64 + lane;
            const float ss = wave_sum(v[k] * v[k]);
            const float vn = v[k] * (1.f / sqrtf(ss * (1.f / 64.f) + EPS)) * ((it & 1) ? gn1 : gn0);
            if (gv_out) gv_out[(size_t)i * 256 + ch] = vn;
            *(LAS unsigned short*)(lds + i * 512 + 64 * ((ch >> 5) ^ (i & 3)) + 2 * (ch & 31)) = (unsigned short)f2bf(vn); }
    }
    __syncthreads();
    const int g = 2 * gp + (wave & 1), ib = wave >> 1, r32 = lane & 31, h = lane >> 5, q = (lane & 15) >> 2, p = lane & 3, blk = (lane >> 4) & 1;
    f32x16 acc[2];
#pragma unroll
    for (int b = 0; b < 2; ++b)
#pragma unroll
        for (int k = 0; k < 16; ++k) acc[b][k] = 0.f;
    { const bf16* wrow = WGB + ((size_t)(g * 128 + 32 * ib + r32)) * 128 + 8 * h;
      const int ns = 2 * (ib + 1);
      bf16x8 af[8];
#pragma unroll
      for (int s = 0; s < 8; ++s) af[s] = *(const bf16x8*)(wrow + 16 * (s < ns ? s : 0));
#pragma unroll
      for (int s = 0; s < 8; ++s) { if (s < ns) {
          const bf16x8 a = af[s];
#pragma unroll
          for (int cb = 0; cb < 2; ++cb) {
              const int col = g * 64 + 32 * cb + 16 * blk + 4 * p, row = 16 * s + 8 * h + q;
              const LAS char* ad = lds + row * 512 + 64 * ((col >> 5) ^ q) + 2 * (col & 31);
              const s16x4 lo = vtr(ad), hi = vtr(ad + 4 * 512);
              const bf16x8 bfr = {lo[0], lo[1], lo[2], lo[3], hi[0], hi[1], hi[2], hi[3]};
              acc[cb] = __builtin_amdgcn_mfma_f32_32x32x16_bf16(a, bfr, acc[cb], 0, 0, 0);
          }
      } } }
#pragma unroll
    for (int cb = 0; cb < 2; ++cb) {
        float uu[16], gb[16]; unsigned short zz[16];
#pragma unroll
        for (int k = 0; k < 16; ++k) { const int i = 32 * ib + crow_c(k) + 4 * h, ch = g * 64 + 32 * cb + r32; const size_t row = (size_t)row0 + i; uu[k] = U[row * 256 + ch]; zz[k] = ZC[row * 256 + ch]; gb[k] = gbs[g * 128 + i]; }
#pragma unroll
        for (int k = 0; k < 16; ++k) { const int i = 32 * ib + crow_c(k) + 4 * h, ch = g * 64 + 32 * cb + r32; const size_t row = (size_t)row0 + i;
            const float s = acc[cb][k] + gb[k];
            MIX[row * 1024 + 768 + ch] = (bf16)f2bf(uu[k] * s * bf2f(zz[k])); }
    }
    __syncthreads();
}
#undef GDI
}

namespace sk {
typedef short bf16x8 __attribute__((ext_vector_type(8)));
template <class P, class F> __device__ __forceinline__ void slab2(const bf16* A, const bf16* Bt, LAS float* part, int lane, int wave, const P& pre, const F& emit) {
    asm volatile("" : "+v"(lane));
    const int r16 = lane & 15, kq = lane >> 4;
    const bf16* ap = A + (size_t)r16 * 1024 + 128 * wave + 8 * kq;
    const bf16* bp = Bt + (size_t)r16 * 1024 + 128 * wave + 8 * kq;
    float pv[4];
#pragma unroll
    for (int reg = 0; reg < 4; ++reg) pv[reg] = pre(16 * wave + 4 * kq + reg);
    bf16x8 b[2][4];
#pragma unroll
    for (int c = 0; c < 2; ++c)
#pragma unroll
        for (int s = 0; s < 4; ++s) b[c][s] = *(const bf16x8*)(bp + (size_t)c * 16 * 1024 + 32 * s);
    bf16x8 a[2][4][4];
#pragma unroll
    for (int rh = 0; rh < 2; ++rh)
#pragma unroll
        for (int rb = 0; rb < 4; ++rb)
#pragma unroll
            for (int s = 0; s < 4; ++s) a[rh][rb][s] = *(const bf16x8*)(ap + (size_t)(4 * rh + rb) * 16 * 1024 + 32 * s);
#pragma unroll
    for (int rh = 0; rh < 2; ++rh) {
#pragma unroll
        for (int rb = 0; rb < 4; ++rb)
#pragma unroll
            for (int c = 0; c < 2; ++c) { f32x4 acc = {0.f, 0.f, 0.f, 0.f};
#pragma unroll
                for (int s = 0; s < 4; ++s) acc = __builtin_amdgcn_mfma_f32_16x16x32_bf16(a[rh][rb][s], b[c][s], acc, 0, 0, 0);
#pragma unroll
                for (int reg = 0; reg < 4; ++reg) part[(wave * 128 + 16 * (4 * rh + rb) + 4 * kq + reg) * 32 + 16 * c + r16] = acc[reg]; }
    }
    __syncthreads();
#pragma unroll
    for (int c = 0; c < 2; ++c)
#pragma unroll
        for (int reg = 0; reg < 4; ++reg) { const int row = 16 * wave + 4 * kq + reg; float sum = 0.f;
#pragma unroll
            for (int pw = 0; pw < 8; ++pw) sum += part[(pw * 128 + row) * 32 + 16 * c + r16];
            emit(row, 16 * c + r16, sum, pv[reg]); }
    __syncthreads();
}
__device__ __forceinline__ void sample_out(const bf16* A, const bf16* Bt, unsigned char* ws, float* out, const float* x_sample, const float* gpost, unsigned* ctl, int l, int u, LAS float* part, int tid, int lane, int wave) {
    asm volatile("" : "+v"(lane));
    const int r16 = lane & 15, kq = lane >> 4;
    const bf16* ap = A + (size_t)r16 * 1024 + 128 * wave + 8 * kq;
    const bf16* bp = Bt + (size_t)r16 * 1024 + 128 * wave + 8 * kq;
    bf16x8 b[2][4];
#pragma unroll
    for (int c = 0; c < 2; ++c)
#pragma unroll
        for (int s2 = 0; s2 < 4; ++s2) b[c][s2] = *(const bf16x8*)(bp + (size_t)c * 16 * 1024 + 32 * s2);
#pragma unroll
    for (int rh = 0; rh < 2; ++rh) { bf16x8 a[4][4];
#pragma unroll
        for (int rb = 0; rb < 4; ++rb)
#pragma unroll
            for (int s2 = 0; s2 < 4; ++s2) a[rb][s2] = *(const bf16x8*)(ap + (size_t)(4 * rh + rb) * 16 * 1024 + 32 * s2);
#pragma unroll
        for (int rb = 0; rb < 4; ++rb)
#pragma unroll
            for (int c = 0; c < 2; ++c) { f32x4 acc = {0.f, 0.f, 0.f, 0.f};
#pragma unroll
                for (int s2 = 0; s2 < 4; ++s2) acc = __builtin_amdgcn_mfma_f32_16x16x32_bf16(a[rb][s2], b[c][s2], acc, 0, 0, 0);
#pragma unroll
                for (int reg = 0; reg < 4; ++reg) part[(wave * 128 + 16 * (4 * rh + rb) + 4 * kq + reg) * 32 + 16 * c + r16] = acc[reg]; }
    }
    __syncthreads();
    float v[2][4];
#pragma unroll
    for (int c = 0; c < 2; ++c)
#pragma unroll
        for (int reg = 0; reg < 4; ++reg) { const int row = 16 * wave + 4 * kq + reg; float sum = 0.f;
#pragma unroll
            for (int pw = 0; pw < 8; ++pw) sum += part[(pw * 128 + row) * 32 + 16 * c + r16];
            v[c][reg] = sum; }
    __syncthreads();
    float* slots = (float*)(ws + pg8::G1_XS) + (size_t)2 * pg8::E_MP * 4 + (size_t)l * 128 * 32;
    unsigned* cnt = ctl + pg8::CW_SEAM + (l * 65 + 64) * 64;
    LAS float* S = part; LAS unsigned* flag = (LAS unsigned*)(part + 128);
#pragma unroll
    for (int reg = 0; reg < 4; ++reg) { float q = v[0][reg] * v[0][reg] + v[1][reg] * v[1][reg];
        q += dppf<0xB1>(q); q += dppf<0x4E>(q); q += dppf<0x141>(q); q += dppf<0x140>(q);
        if (r16 == 0) __hip_atomic_store(slots + (size_t)(16 * wave + 4 * kq + reg) * 32 + u, q, __ATOMIC_RELAXED, __HIP_MEMORY_SCOPE_AGENT); }
    asm volatile("s_waitcnt vmcnt(0)" ::: "memory"); __syncthreads();
    if (tid == 0) __hip_atomic_fetch_add(cnt, 1u, __ATOMIC_RELAXED, __HIP_MEMORY_SCOPE_AGENT);
    if (wave == 0) { bool dead = false; unsigned sp = 0;
        while ((unsigned)__builtin_amdgcn_readfirstlane(__hip_atomic_load(cnt, __ATOMIC_RELAXED, __HIP_MEMORY_SCOPE_AGENT)) < 32u) { __builtin_amdgcn_s_sleep(2); if (++sp > (1u << 16)) { dead = true; break; } }
        __builtin_amdgcn_fence(__ATOMIC_ACQUIRE, "agent");
        if (lane == 0) flag[0] = dead ? 1u : 0u; }
    asm volatile("s_waitcnt vmcnt(0) lgkmcnt(0)" ::: "memory"); __syncthreads();
    if (tid < 128) { float ss = 0.f;
        for (int j = 0; j < 32; ++j) ss += __hip_atomic_load(slots + (size_t)tid * 32 + j, __ATOMIC_RELAXED, __HIP_MEMORY_SCOPE_AGENT);
        S[tid] = flag[0] ? __builtin_nanf("") : 1.f / sqrtf(ss * (1.f / 1024.f) + 1e-6f); }
    __syncthreads();
    bf16* XB = (bf16*)(ws + WS_XB); float* RSN = (float*)(ws + WS_RS) + MPAD;
    unsigned short xr[4][2]; float gp2[2];
#pragma unroll
    for (int c = 0; c < 2; ++c) { gp2[c] = gpost[32 * u + 16 * c + r16];
#pragma unroll
        for (int reg = 0; reg < 4; ++reg) xr[reg][c] = XB[(size_t)(MP + 16 * wave + 4 * kq + reg) * 1024 + 32 * u + 16 * c + r16]; }
#pragma unroll
    for (int reg = 0; reg < 4; ++reg) { const int row = 16 * wave + 4 * kq + reg; const float r = S[row]; float q = 0.f;
#pragma unroll
        for (int c = 0; c < 2; ++c) { const int col = 32 * u + 16 * c + r16; const size_t idx = (size_t)(MP + row) * 1024 + col;
            const float x = bf2f(xr[reg][c]);
            const float y = x + v[c][reg] * r * gp2[c];
            if (l == 0) { XB[idx] = (bf16)f2bf(y); q += y * y; } else out[O_Y_S + (size_t)row * 1024 + col] = y; }
        if (l == 0) { q += dppf<0xB1>(q); q += dppf<0x4E>(q); q += dppf<0x141>(q); q += dppf<0x140>(q);
            if (r16 == 0) __hip_atomic_fetch_add(RSN + MP + row, q, __ATOMIC_RELAXED, __HIP_MEMORY_SCOPE_AGENT); } }
    __syncthreads();
}
__device__ __forceinline__ void emit_g1_sample(unsigned char* ws, float* out, int l, int sb, int c, float v) {
    const size_t row = (size_t)MP + sb;
    if (c < 512) ((bf16*)(ws + WS_Q))[row * 512 + c] = (bf16)f2bf(v * pg8::QSCALE);
    else if (c < 768) out[O_KC_S + ((size_t)l * DECB + sb) * 256 + (c - 512)] = v;
    else if (c < 1024) out[O_KS_S + ((size_t)l * DECB + sb) * 256 + (c - 768)] = v;
    else if (c < 1280) { ((float*)(ws + WS_KWF))[row * 256 + (c - 1024)] = v; out[O_KW_S + (((size_t)l * DECB + sb) * 512 + 511) * 256 + (c - 1024)] = v; }
    else if (c < 1792) ((bf16*)(ws + WS_ZA))[row * 512 + (c - 1280)] = (bf16)f2bf(siluf_(v));
    else if (c < 2048) { ((float*)(ws + WS_PIN))[row * 256 + (c - 1792)] = v; out[O_PL_S + (((size_t)l * DECB + sb) * 15 + 14) * 256 + (c - 1792)] = v; }
    else if (c < 2304) ((bf16*)(ws + WS_ZB))[row * 256 + (c - 2048)] = (bf16)f2bf(siluf_(v));
    else if (c < 2560) ((float*)(ws + WS_U))[row * 256 + (c - 2304)] = v;
    else if (c < 2816) ((float*)(ws + WS_V))[row * 256 + (c - 2560)] = v;
    else if (c < 3072) ((bf16*)(ws + WS_ZC))[row * 256 + (c - 2816)] = (bf16)f2bf(siluf_(v));
}
}

namespace pl {
typedef short bf16x8 __attribute__((ext_vector_type(8)));
typedef float f32x16 __attribute__((ext_vector_type(16)));
constexpr int OFF_WPT = 0, OFF_DF = 32768, POOL_LDS = 65536;
constexpr int crow_c(int i) { return (i & 3) + 8 * (i >> 2); }
#define PDI __device__ __forceinline__
PDI void stage_weights(const float* pw, LAS char* lds, int tid) {
    for (int q = tid; q < 2048; q += 512) { const int c8 = q & 7, e = (q >> 3) & 63, g = q >> 9; const float* s = pw + ((size_t)g * 64 + 8 * c8) * 64 + e;
        v4u o; o.x = pk2(s[0], s[64]); o.y = pk2(s[128], s[192]); o.z = pk2(s[256], s[320]); o.w = pk2(s[384], s[448]);
        *(LAS v4u*)(lds + OFF_WPT + (g * 64 + e) * 128 + 16 * (c8 ^ ((e >> 1) & 7))) = o; }
}
PDI void put_diff(LAS char* lds, int tok, int ch, float d) { *(LAS unsigned short*)(lds + OFF_DF + tok * 512 + 16 * ((ch >> 3) ^ (tok & 15)) + 2 * (ch & 7)) = (unsigned short)f2bf(d); }
template <int W> PDI void diff_prompt(const float* pin_b, int t0, int ch, int half, LAS char* lds) {
    const int ts = t0 + 32 * half;
    float cur[32], old[32];
#pragma unroll
    for (int i = 0; i < 32; ++i) { cur[i] = pin_b[(size_t)(ts + i) * 256 + ch]; const int to = ts + i - W; old[i] = to >= 0 ? pin_b[(size_t)to * 256 + ch] : 0.f; }
    float s = 0.f;
#pragma unroll
    for (int k = 1; k <= W; ++k) { const int tp = ts - k; s += tp >= 0 ? pin_b[(size_t)tp * 256 + ch] : 0.f; }
#pragma unroll
    for (int i = 0; i < 32; ++i) { s += cur[i] - old[i]; const int t = ts + i; const int cnt = (t + 1) < W ? (t + 1) : W;
        put_diff(lds, 32 * half + i, ch, s * __builtin_amdgcn_rcpf((float)cnt) - cur[i]); }
}
template <int W> PDI void diff_sample(const float* PIN, const float* state_l, int sb0, int ch, int half, LAS char* lds) {
#pragma unroll 1
    for (int i0 = 0; i0 < 16; i0 += 2) { float v[2][W];
#pragma unroll
        for (int j = 0; j < 2; ++j) { const int sb = sb0 + 16 * half + i0 + j; v[j][0] = PIN[(size_t)(MP + sb) * 256 + ch];
#pragma unroll
            for (int k = 1; k < W; ++k) v[j][k] = state_l[((size_t)sb * 15 + (15 - k)) * 256 + ch]; }
#pragma unroll
        for (int j = 0; j < 2; ++j) { float s = v[j][0];
#pragma unroll
            for (int k = 1; k < W; ++k) s += v[j][k];
            put_diff(lds, 16 * half + i0 + j, ch, s * (1.0f / (float)W) - v[j][0]); } }
}
PDI void mma_store(const float* psc, const bf16* ZB, bf16* MIX, size_t row0, int nth, LAS char* lds, int lane, int wave) {
    const int g = wave & 3, th = wave >> 2, r32 = lane & 31, h = lane >> 5;
    if (th >= nth) return;
    f32x16 acc[2];
#pragma unroll
    for (int eb = 0; eb < 2; ++eb)
#pragma unroll
        for (int k = 0; k < 16; ++k) acc[eb][k] = 0.f;
    const int tok = 32 * th + r32;
#pragma unroll
    for (int s = 0; s < 4; ++s) {
        const bf16x8 a = *(const LAS bf16x8*)(lds + OFF_DF + tok * 512 + 16 * ((8 * g + 2 * s + h) ^ (tok & 15)));
#pragma unroll
        for (int eb = 0; eb < 2; ++eb) { const int e = 32 * eb + r32;
            const bf16x8 b = *(const LAS bf16x8*)(lds + OFF_WPT + (g * 64 + e) * 128 + 16 * ((2 * s + h) ^ ((e >> 1) & 7)));
            acc[eb] = __builtin_amdgcn_mfma_f32_32x32x16_bf16(a, b, acc[eb], 0, 0, 0); }
    }
#pragma unroll
    for (int eb = 0; eb < 2; ++eb) { const int ch = g * 64 + 32 * eb + r32; const float sc = psc[ch];
        unsigned short zz[16];
#pragma unroll
        for (int k = 0; k < 16; ++k) zz[k] = ZB[(row0 + 32 * th + crow_c(k) + 4 * h) * 256 + ch];
#pragma unroll
        for (int k = 0; k < 16; ++k) { const size_t row = row0 + 32 * th + crow_c(k) + 4 * h; MIX[row * 1024 + 512 + ch] = (bf16)f2bf(acc[eb][k] * sc * bf2f(zz[k])); } }
}
#undef PDI
}

__global__ void __launch_bounds__(NWAVES * 64, 2) hymba_fwd(Args args) {
    extern __shared__ __attribute__((aligned(16))) unsigned char lds[];
    Frame F;
    F.lds = (LAS unsigned char*)lds;
    F.MISC = (volatile LAS unsigned*)(F.lds + MISC_OFF);
    F.tid = threadIdx.x; F.lane = F.tid & 63; F.wave = __builtin_amdgcn_readfirstlane(F.tid >> 6);
    F.G = gridDim.x; { const int bx = blockIdx.x; F.vcu = (F.G % 8 == 0) ? (bx % 8) * (F.G / 8) + bx / 8 : bx; }
    F.ctl = (gu32*)(args.ws + WS_CTL);
    for (int u = F.tid; u < (LDS_BYTES - LDSCTL_OFF) / 4; u += NWAVES * 64) ((LAS unsigned*)(F.lds + LDSCTL_OFF))[u] = 0u;
    __syncthreads();
    XcdBarrier bar; bar.bar = (unsigned*)(F.ctl + CW_BAR); bar.x = 0; bar.st = nullptr;
    if (N_LAUNCHES == 1) bar = xcd_barrier_post((unsigned*)(F.ctl + CW_BAR), F.MISC + 8, F.wave);
#define GRID_BAR() do { if (N_LAUNCHES == 1) xcd_barrier(bar, F.wave); } while (0)
    const int lo = args.ph_lo, hi = args.ph_hi;
#define IN(k) (lo <= (k) && (k) < hi)
#define PHASE_PTRS() kargs_t ka = (kargs_t)__builtin_amdgcn_kernarg_segment_ptr(); asm volatile("" : "+s"(ka)); unsigned char* ws = ka->ws; const float* x_prompt = (const float*)ka->in[0]; const float* x_sample = (const float*)ka->in[1]; const float* cache_cmp = (const float*)ka->in[2]; const float* cache_sel = (const float*)ka->in[3]; const float* cache_win = (const float*)ka->in[4]; const float* state_pool = (const float*)ka->in[5]; const int* page_table = (const int*)ka->in[6]; const float* norm_pre = (const float*)ka->in[7]; const float* w_in = (const float*)ka->in[8]; const float* cmp_pe = (const float*)ka->in[9]; const float* cmp_w1 = (const float*)ka->in[10]; const float* cmp_w2 = (const float*)ka->in[11]; const float* pool_w = (const float*)ka->in[12]; const float* pool_scale = (const float*)ka->in[13]; const float* gmlp_norm = (const float*)ka->in[14]; const float* gmlp_ws = (const float*)ka->in[15]; const float* gmlp_bs = (const float*)ka->in[16]; const float* w_out = (const float*)ka->in[17]; const float* norm_post = (const float*)ka->in[18]; float* out = ka->out; bf16* W1T = (bf16*)(ws + WS_W1T); bf16* W2T = (bf16*)(ws + WS_W2T); float* RS = (float*)(ws + WS_RS); float* KCP = (float*)(ws + WS_KCP); float* KCS = (float*)(ws + WS_KCS); float* GT = (float*)(ws + WS_GT); bf16* XB = (bf16*)(ws + WS_XB); bf16* MIX = (bf16*)(ws + WS_MIX); bf16* QB = (bf16*)(ws + WS_Q); bf16* ZA = (bf16*)(ws + WS_ZA); bf16* ZB = (bf16*)(ws + WS_ZB); bf16* ZC = (bf16*)(ws + WS_ZC); float* KWF = (float*)(ws + WS_KWF); float* PIN = (float*)(ws + WS_PIN); float* U = (float*)(ws + WS_U); float* V = (float*)(ws + WS_V); bf16* OUTB = (bf16*)(ws + WS_OUTF); bf16* KSB = (bf16*)(ws + WS_KSB); bf16* KWB = (bf16*)(ws + WS_KWB); (void)KSB; (void)KWB; bf16* WGB = (bf16*)(ws + WS_WGB); (void)WGB;  constexpr size_t W1T_L = (size_t)7 * MiB / 2, W2T_L = (size_t)DM * DM;
#define LAYER_PTRS() float* kc_p = out + O_KC_P + (size_t)l * MP * 256; float* kc_s = out + O_KC_S + (size_t)l * DECB * 256; float* ks_p = out + O_KS_P + (size_t)l * MP * 256; float* ks_s = out + O_KS_S + (size_t)l * DECB * 256; (void)kc_p; (void)kc_s; (void)ks_p; (void)ks_s
#define PHASE_IDS() int lane_ = (int)__builtin_amdgcn_mbcnt_hi(~0u, __builtin_amdgcn_mbcnt_lo(~0u, 0u)); asm volatile("" : "+v"(lane_)); int wv_ = F.wave, bx_ = (int)blockIdx.x, G_ = F.G; asm volatile("" : "+s"(wv_), "+s"(bx_), "+s"(G_)); const int lane = lane_, wave = wv_, bx = bx_, G = G_, tid = wave * 64 + lane, vcu = (G % 8 == 0) ? (bx % 8) * (G / 8) + bx / 8 : bx, gw = vcu * NWAVES + wave, NGW = G * NWAVES; (void)tid; (void)gw; (void)NGW
#define BOTH(k) (IN(k) && IN((k) + 1))

    if (IN(0)) {
        PHASE_IDS(); PHASE_PTRS();
        LAS float* scr = (LAS float*)(F.lds + RING_OFF + wave * 16384);
        { constexpr int NB_IN = 49, NB_OUT = 16, I_IN = NB_IN * 32, I_OUT = NB_OUT * 32, I_L = I_IN + I_OUT;
          for (int it = gw; it < DEPTH * I_L; it += NGW) {
              const int l = it / I_L; int r = it % I_L;
              const bool isIn = r < I_IN; if (!isIn) r -= I_IN;
              const int nb = r >> 5, kb = r & 31, k0 = 32 * kb, col = 64 * nb + lane;
              const int nsrc = isIn ? DIN : DM;
              const float* W = isIn ? w_in + (size_t)l * DM * DIN : w_out + (size_t)l * DM * DM;
              const float* gk = norm_pre + l * DM;
              float v[32];
              if (col < nsrc) {
#pragma unroll
                  for (int k = 0; k < 32; ++k) v[k] = W[(size_t)(k0 + k) * nsrc + col];
                  if (isIn) {
#pragma unroll
                      for (int k = 0; k < 32; ++k) v[k] *= gk[k0 + k]; }
                  const int drow = isIn ? (col < 1280 ? col : (col < 1304 ? 3072 + (col - 1280) : col - 24)) : col;
                  bf16* dst = (isIn ? W1T + l * W1T_L : W2T + l * W2T_L) + (size_t)drow * DM + k0;
#pragma unroll
                  for (int q = 0; q < 4; ++q) { v4u o; o.x = pk2(v[8 * q], v[8 * q + 1]); o.y = pk2(v[8 * q + 2], v[8 * q + 3]); o.z = pk2(v[8 * q + 4], v[8 * q + 5]); o.w = pk2(v[8 * q + 6], v[8 * q + 7]);
                      *(v4u*)(dst + 8 * q) = o; }
              }
          } }
        for (int i = gw * 64 + lane; i < DEPTH * 232 * 128; i += NGW * 64) { const int l = i / (232 * 128), r = i % (232 * 128);
            *(v4u*)(W1T + l * W1T_L + (size_t)3096 * DM + (size_t)r * 8) = (v4u){0u, 0u, 0u, 0u}; }
        for (int i8 = gw * 64 + lane; i8 < DEPTH * 4 * 128 * 128 / 8; i8 += NGW * 64) { const int e0 = i8 * 8, j0 = e0 & 127, i = (e0 >> 7) & 127;
            const f32x4 a = *(const f32x4*)(gmlp_ws + e0), b = *(const f32x4*)(gmlp_ws + e0 + 4);
            v4u o; o.x = pk2(j0 <= i ? a.x : 0.f, j0 + 1 <= i ? a.y : 0.f); o.y = pk2(j0 + 2 <= i ? a.z : 0.f, j0 + 3 <= i ? a.w : 0.f);
            o.z = pk2(j0 + 4 <= i ? b.x : 0.f, j0 + 5 <= i ? b.y : 0.f); o.w = pk2(j0 + 6 <= i ? b.z : 0.f, j0 + 7 <= i ? b.w : 0.f);
            *(v4u*)(WGB + e0) = o; }
        for (int m0 = gw; m0 < MR; m0 += 2 * NGW) { f32x4 xv[2][4];
#pragma unroll
            for (int q = 0; q < 2; ++q) { const int m = m0 + q * NGW; if (m < MR) { const f32x4* xr = (const f32x4*)(m < MP ? x_prompt + (size_t)m * DM : x_sample + (size_t)(m - MP) * DM) + lane;
#pragma unroll
                for (int j = 0; j < 4; ++j) xv[q][j] = __builtin_nontemporal_load(xr + 64 * j); } }
#pragma unroll
            for (int q = 0; q < 2; ++q) { const int m = m0 + q * NGW; if (m < MR) { float s = 0.f; v2u* o8 = (v2u*)(XB + (size_t)m * DM) + lane;
#pragma unroll
                for (int j = 0; j < 4; ++j) { const f32x4 x = xv[q][j]; s += (x.x * x.x + x.y * x.y) + (x.z * x.z + x.w * x.w); v2u w; w.x = pk2(x.x, x.y); w.y = pk2(x.z, x.w); o8[64 * j] = w; }
                s = wave_sum(s); if (lane == 0) RS[m] = s; } } }
        for (int i = gw * 64 + lane; i < MPAD; i += NGW * 64) RS[MPAD + i] = 0.f;
        {
          const size_t m4 = (size_t)DEPTH * DECB * 14 * 64;
          for (size_t i = (size_t)bx * 512 + tid; i < m4; i += (size_t)G * 512) { const size_t lb = i / (14 * 64), r = i % (14 * 64);
              *(f32x4*)(out + O_PL_S + lb * 15 * 256 + r * 4) = *(const f32x4*)(state_pool + lb * 15 * 256 + 256 + r * 4); } }
        if (BOTH(0)) GRID_BAR();
    }

#pragma unroll
    for (int l = 0; l < DEPTH; ++l) {
        const int pb = 5 * l;
        if (IN(pb + 1)) {
            int cl_ = ((int)blockIdx.x >> 3) & 3; asm volatile("" : "+s"(cl_));
#pragma nounroll
          for (int step = 0; step < 3; ++step) {
            if (step == 1) {
                PHASE_IDS(); PHASE_PTRS();
                struct JobS { const float* cache; int pagev; float* kcs; int l, bx, G;
                    __device__ __forceinline__ const float* src(int i) const { const int u = bx + i * G, n = u & 31; const int page = __builtin_amdgcn_readlane(pagev, i); return cache + (((size_t)l * NPHYS + page) * PAGE + (n & 1) * 64) * 256; }
                    __device__ __forceinline__ float* dst(int i) const { const int u = bx + i * G; return kcs + ((size_t)l * DECB * 32 + u) * 256; } };
                const int n = (DECB * 32 - bx + G - 1) / G;
                int pagev = 0; { const int u = bx + lane * G; if (lane < n) pagev = page_table[(u >> 5) * NPAGES + ((u & 31) >> 1)]; }
                const JobS J{cache_cmp, pagev, KCS, l, bx, G};
                cmpk::run(J, n, cmp_pe + (size_t)l * 2 * 64 * 64, cmp_w1 + (size_t)l * 2 * 64 * 64, cmp_w2 + (size_t)l * 2 * 64 * 64, (LAS char*)(F.lds + RING_OFF), tid, lane, wave);
            } else {
                PHASE_IDS(); PHASE_PTRS(); LAYER_PTRS();
                struct RangeOrder { pg8::StaticOrder B; int i0, i1;
                    __device__ __forceinline__ bool next(int i, pg8::Unit& u) const { return (i0 + i < i1) && B.next(i0 + i, u); }
                    __device__ __forceinline__ void a_ready(const pg8::Unit&) const {}
                    __device__ __forceinline__ void done(const pg8::Unit&) const {} };
                pg8::Gemm g{XB, W1T + l * W1T_L, MP, 3072, DM}; RangeOrder S; S.B.init(MP, 3072, G, bx);
                S.i0 = step == 0 ? 0 : cl_; S.i1 = step == 0 ? cl_ : 3;
                pg8::EpiG1 E{ws, out, l};
                pg8::gemm_phase<pg8::EpiG1, RangeOrder, true, true>(F.lds + RING_OFF, g, S, E, wave);
            }
            __syncthreads();
          }
            PHASE_IDS(); PHASE_PTRS(); LAYER_PTRS();
            { const bf16* W1 = W1T + l * W1T_L;
              for (int u = vcu; u < 96 + 129; u += G) {
                  if (u < 96) { const int c0 = 32 * u;
                      sk::slab2(XB + (size_t)MP * DM, W1 + (size_t)c0 * DM, (LAS float*)(F.lds + RING_OFF), lane, wave, [&](int r) { return RS[(size_t)l * MPAD + MP + r]; },
                                [&](int r, int c, float v, float ssq) { sk::emit_g1_sample(ws, out, l, r, c0 + c, v * (1.f / sqrtf(ssq * (1.f / DM) + EPS))); });
                  } else { const int rb = u - 96;
                      sk::slab2(XB + (size_t)rb * 128 * DM, W1 + (size_t)3072 * DM, (LAS float*)(F.lds + RING_OFF), lane, wave, [&](int r) { return RS[(size_t)l * MPAD + rb * 128 + r]; },
                                [&](int r, int c, float v, float ssq) { const int row = rb * 128 + r;
                          if (c < 24) GT[(size_t)row * 32 + c] = pg8::sigmoidf_(v * (1.f / sqrtf(ssq * (1.f / DM) + EPS))); }); } } }
            if (BOTH(pb + 1)) GRID_BAR();
        }
        if (IN(pb + 2)) {
            int sf_ = ((int)blockIdx.x >> 3) & 1; asm volatile("" : "+s"(sf_));
#pragma nounroll
          for (int step = 0; step < 2; ++step) {
           if ((step == 0) == (sf_ != 0)) {
            PHASE_IDS(); PHASE_PTRS(); LAYER_PTRS();
            unsigned* cntSA = (unsigned*)F.ctl + pg8::CW_SEAM + (130 + l) * 64;
            const AttnPtrs A{QB, GT, KCS, ks_s, KWF, cache_sel, cache_win, page_table, ZA, MIX, cntSA};
            for (int u = bx; u < DECB * 2; u += G) sample_unit(A, l, u >> 1, u & 1, (LAS float*)(F.lds + RING_OFF), tid, lane, wave);
           } else {
            PHASE_IDS(); PHASE_PTRS(); LAYER_PTRS();
            { struct JobP { const float* kc; float* kcp; int bx, G;
                  __device__ __forceinline__ const float* src(int i) const { return kc + (size_t)(bx + i * G) * 64 * 256; }
                  __device__ __forceinline__ float* dst(int i) const { return kcp + (size_t)(bx + i * G) * 256; } };
              const JobP J{kc_p, KCP, bx, G};
              const int n = (NB * 64 - bx + G - 1) / G;
              cmpk::run<JobP, true>(J, n, cmp_pe + (size_t)l * 2 * 64 * 64, cmp_w1 + (size_t)l * 2 * 64 * 64, cmp_w2 + (size_t)l * 2 * 64 * 64, (LAS char*)(F.lds + RING_OFF), tid, lane, wave);
              asm volatile("s_waitcnt vmcnt(0)" ::: "memory");
              __syncthreads();
              if (tid == 0) for (int i = 0; i < n; ++i) __hip_atomic_fetch_add((unsigned*)F.ctl + pg8::CW_SEAM + (132 + l * 4 + ((bx + i * G) >> 6)) * 64, 1u, __ATOMIC_RELAXED, __HIP_MEMORY_SCOPE_AGENT); }
            { LAS char* PL = (LAS char*)(F.lds + RING_OFF);
              const float* psc = pool_scale + l * 256;
              pl::stage_weights(pool_w + (size_t)l * 4 * 64 * 64, PL, tid);
              __syncthreads();
              for (int u = bx; u < MP / 64 + DECB / 32; u += G) {
                  const int ch = tid & 255, half = tid >> 8;
                  if (u < MP / 64) { const int row0 = u * 64, b = row0 >> 12, t0 = row0 & (SEQ - 1); const float* pin_b = PIN + (size_t)b * SEQ * 256;
                      switch (ch >> 6) { case 0: pl::diff_prompt<2>(pin_b, t0, ch, half, PL); break; case 1: pl::diff_prompt<4>(pin_b, t0, ch, half, PL); break;
                                         case 2: pl::diff_prompt<8>(pin_b, t0, ch, half, PL); break; default: pl::diff_prompt<16>(pin_b, t0, ch, half, PL); break; }
                      __syncthreads();
                      pl::mma_store(psc, ZB, MIX, (size_t)row0, 2, PL, lane, wave);
                  } else { const int sb0 = (u - MP / 64) * 32;
                      const float* st_l = state_pool + (size_t)l * DECB * 15 * 256;
                      switch (ch >> 6) { case 0: pl::diff_sample<2>(PIN, st_l, sb0, ch, half, PL); break; case 1: pl::diff_sample<4>(PIN, st_l, sb0, ch, half, PL); break;
                                         case 2: pl::diff_sample<8>(PIN, st_l, sb0, ch, half, PL); break; default: pl::diff_sample<16>(PIN, st_l, sb0, ch, half, PL); break; }
                      __syncthreads();
                      pl::mma_store(psc, ZB, MIX, (size_t)MP + sb0, 1, PL, lane, wave); }
                  __syncthreads();
              } }
            { const float* gn = gmlp_norm + l * 256; const float* gws = gmlp_ws + (size_t)l * 4 * 128 * 128; const float* gbs = gmlp_bs + l * 4 * 128;
              for (int u2 = bx; u2 < 2 * (MP / CHUNK); u2 += G) { const int u = u2 >> 1, row0 = u * CHUNK, b = row0 >> 12, t0 = row0 & (SEQ - 1);
                  gm::unit(V, U, ZC, MIX, gn, WGB + (size_t)l * 4 * 128 * 128, gbs, t0 == SEQ - CHUNK ? out + O_GV_P + ((size_t)l * NB + b) * CHUNK * 256 : nullptr, row0, u2 & 1, (LAS char*)(F.lds + RING_OFF), tid, lane, wave); }
              for (int it = gw; it < DECB * 4; it += NGW) { const int sb = it >> 2, g = it & 3, ch = g * 64 + lane; const size_t row = (size_t)MP + sb;
                  const float v = V[row * 256 + ch]; const float ss = wave_sum(v * v);
                  const float vn = v * (1.f / sqrtf(ss * (1.f / 64.f) + EPS)) * gn[ch];
                  out[O_GV_S + ((size_t)l * DECB + sb) * 256 + ch] = vn;
                  const float s = gws[(size_t)g * 128 * 128] * vn + gbs[g * 128];
                  MIX[row * 1024 + 768 + ch] = (bf16)f2bf(U[row * 256 + ch] * s * bf2f(ZC[row * 256 + ch])); }
            }
            if (G == 256 && (vcu < 64 || bx < 4)) {
                asm volatile("s_waitcnt vmcnt(0)" ::: "memory");
                __syncthreads();
                if (tid == 0) { __builtin_amdgcn_fence(__ATOMIC_RELEASE, "agent"); asm volatile("s_waitcnt vmcnt(0)" ::: "memory");
                    __hip_atomic_fetch_add((unsigned*)F.ctl + pg8::CW_SEAM + (140 + l) * 64, 1u, __ATOMIC_RELAXED, __HIP_MEMORY_SCOPE_AGENT); } }
           }
            __syncthreads();
          }
        }
        if (IN(pb + 3)) {
            PHASE_IDS(); PHASE_PTRS(); LAYER_PTRS();
            unsigned* cntSA = (unsigned*)F.ctl + pg8::CW_SEAM + (130 + l) * 64;
            const AttnPtrs A{QB, GT, KCS, ks_s, KWF, cache_sel, cache_win, page_table, ZA, MIX, cntSA};
            (void)A;
            const att::Ptrs AP{QB, GT, KCP, KSB, KWB, ZA, MIX};
            { const int bq = (vcu >> 6) & 3;
              if (wave == 0) { unsigned sp = 0; unsigned* ck = (unsigned*)F.ctl + pg8::CW_SEAM + (132 + l * 4 + bq) * 64;
                  while ((unsigned)__builtin_amdgcn_readfirstlane(__hip_atomic_load(ck, __ATOMIC_RELAXED, __HIP_MEMORY_SCOPE_AGENT)) < 64u) { __builtin_amdgcn_s_sleep(2); if (++sp > (1u << 16)) break; }
                  __builtin_amdgcn_fence(__ATOMIC_ACQUIRE, "agent"); }
              asm volatile("s_waitcnt vmcnt(0) lgkmcnt(0)" ::: "memory"); __syncthreads(); }
            const int sct = (int)((att::SIDE_N4 + (unsigned)G * 512u - 1u) / ((unsigned)G * 512u)), sch2 = (sct + 1) / 2;
            att::Side sd{cache_win, out + O_KW_S, l * sch2, (l == DEPTH - 1) ? sct : ((l + 1) * sch2 < sct ? (l + 1) * sch2 : sct), G, bx, 0};
            if (G == 256 && (vcu & 31) < 4) {
                if (wave == 0) { unsigned sp = 0;
                    while ((unsigned)__builtin_amdgcn_readfirstlane(__hip_atomic_load(cntSA, __ATOMIC_RELAXED, __HIP_MEMORY_SCOPE_AGENT)) < (unsigned)(DECB * 2)) { __builtin_amdgcn_s_sleep(2); if (++sp > (1u << 16)) break; }
                    { unsigned* cm = (unsigned*)F.ctl + pg8::CW_SEAM + (140 + l) * 64;
                      while ((unsigned)__builtin_amdgcn_readfirstlane(__hip_atomic_load(cm, __ATOMIC_RELAXED, __HIP_MEMORY_SCOPE_AGENT)) < 66u) { __builtin_amdgcn_s_sleep(2); if (++sp > (1u << 16)) break; } }
                    __builtin_amdgcn_fence(__ATOMIC_ACQUIRE, "agent"); }
                asm volatile("s_waitcnt vmcnt(0) lgkmcnt(0)" ::: "memory"); __syncthreads();
                const int uo = (vcu >> 5) * 4 + (vcu & 31);
                sk::sample_out(MIX + (size_t)MP * DM, W2T + l * W2T_L + (size_t)32 * uo * DM, ws, out, x_sample, norm_post + l * DM, (unsigned*)F.ctl, l, uo, (LAS float*)(F.lds + RING_OFF), tid, lane, wave);
            }
            { const int bk = vcu >> 5; unsigned* qctr = (unsigned*)F.ctl + pg8::CW_SEAM + (142 + l * 8 + bk) * 64; LAS unsigned* qw = (LAS unsigned*)(F.lds + 143360);
              unsigned tk = 0u; if (tid == 0) tk = __hip_atomic_fetch_add(qctr, 1u, __ATOMIC_RELAXED, __HIP_MEMORY_SCOPE_AGENT);
              for (;;) {
                  if (tid == 0) *qw = tk;
                  __syncthreads();
                  const unsigned uq = (unsigned)__builtin_amdgcn_readfirstlane((int)*qw);
                  __syncthreads();
                  if (uq >= 64u) break;
                  if (tid == 0) tk = __hip_atomic_fetch_add(qctr, 1u, __ATOMIC_RELAXED, __HIP_MEMORY_SCOPE_AGENT);
                  att::unit(AP, bk >> 1, bk & 1, 63 - (int)uq, (LAS char*)(F.lds + RING_OFF), tid, lane, wave, sd); } }
            while (sd.c < sd.cend || sd.pend) att::side_step(sd, tid, wave, (LAS char*)(F.lds + RING_OFF));

            if (BOTH(pb + 3)) GRID_BAR();
        }
        if (IN(pb + 4)) {
            PHASE_IDS(); PHASE_PTRS(); LAYER_PTRS();
            pg8::Gemm g{MIX, W2T + l * W2T_L, MP, DM, DM}; pg8::StaticOrder S; S.init(MP, DM, G, bx);
            if (G == 256) {
                pg8::EpiG2F E{ws, out, x_prompt, norm_post + l * DM, (unsigned*)F.ctl, l};
                pg8::gemm_phase<pg8::EpiG2F, pg8::StaticOrder, false, true>(F.lds + RING_OFF, g, S, E, wave);
            }
            if (IN(pb + 4) && pb + 6 < hi && l + 1 < DEPTH) GRID_BAR();
        }
    }
#undef IN
#undef BOTH
}

extern "C" void kernel_launch(void* const* d_in, const int* in_sizes, int n_in, void* d_out, int out_size, void* d_ws, size_t ws_size, hipStream_t stream) {
    static int grid = 0;
    if (grid == 0) {
        if (n_in != 19 || (size_t)out_size != O_END || ws_size < WS_END) { fprintf(stderr, "kernel_launch: unexpected shapes (n_in %d, out %d, ws %zu); nothing launched\n", n_in, out_size, ws_size); grid = -1; return; }
        int dev = 0, cus = 0, per_cu = 0;
        if (hipGetDevice(&dev) != hipSuccess || hipDeviceGetAttribute(&cus, hipDeviceAttributeMultiprocessorCount, dev) != hipSuccess) { grid = -1; return; }
        if (hipFuncSetAttribute((const void*)hymba_fwd, hipFuncAttributeMaxDynamicSharedMemorySize, LDS_BYTES) != hipSuccess) { fprintf(stderr, "kernel_launch: hipFuncSetAttribute failed\n"); grid = -1; return; }
        if (hipOccupancyMaxActiveBlocksPerMultiprocessor(&per_cu, (const void*)hymba_fwd, NWAVES * 64, LDS_BYTES) != hipSuccess || per_cu < 1)
            fprintf(stderr, "kernel_launch: occupancy query reports %d workgroups per CU\n", per_cu);
        (void)hipGetLastError();
        grid = cus;
    }
    if (grid < 0) return;
    if (hipMemsetAsync((char*)d_ws + WS_CTL, 0, CTL_ZERO_BYTES, stream) != hipSuccess) return;
    Args a{};
    for (int i = 0; i < 19; ++i) a.in[i] = d_in[i];
    a.out = (float*)d_out; a.ws = (unsigned char*)d_ws;
    if (N_LAUNCHES == 1) { a.ph_lo = 0; a.ph_hi = NPHASES; hipLaunchKernelGGL(hymba_fwd, dim3(grid), dim3(NWAVES * 64), LDS_BYTES, stream, a); }
    else for (int p = 0; p < NPHASES; ++p) { a.ph_lo = p; a.ph_hi = p + 1; hipLaunchKernelGGL(hymba_fwd, dim3(grid), dim3(NWAVES * 64), LDS_BYTES, stream, a); }
}
```
